# Optimizing an MI355X kernel written in HIP

```python
import math
import jax, jax.numpy as jnp
from jax import lax
import numpy as np

D_MODEL = 1024
BATCH = 2
SEQ = 8192
DEPTH = 1

ATTN_WIDTH = D_MODEL // 2
ATTN_HEAD_DIM = 64
N_ATTN_HEADS = ATTN_WIDTH // ATTN_HEAD_DIM
MLSTM_WIDTH = D_MODEL - ATTN_WIDTH
N_MLSTM_HEADS = 4
MLSTM_HEAD_DIM = MLSTM_WIDTH // N_MLSTM_HEADS
MLSTM_CHUNK = 64
CONV_WIDTH = 4
DILATED_PATTERNS = ((128, 1), (512, 4), (2048, 16))
ATTN_BLOCK = 128
ATTN_SCALE = ATTN_HEAD_DIM ** -0.5
D_FF = ((8 * D_MODEL // 3 + 255) // 256) * 256
N_MOD = 6
RMS_EPS = 1e-6
IN_SPLITS = (ATTN_WIDTH, ATTN_WIDTH, ATTN_WIDTH,
             MLSTM_WIDTH, MLSTM_WIDTH, MLSTM_WIDTH,
             MLSTM_WIDTH,
             N_MLSTM_HEADS, N_MLSTM_HEADS)
IN_COLS = sum(IN_SPLITS)

kernel_name = "hymba_dilated_attn_mlstm_adaln_block"


def rms_norm(x, g):
    xf = x.astype(jnp.float32)
    y = xf * lax.rsqrt(jnp.mean(xf * xf, axis=-1, keepdims=True) + RMS_EPS)
    return (y * g.astype(jnp.float32)).astype(x.dtype)


def modulate(h, shift, scale):
    return h * (1 + scale[:, None, :]) + shift[:, None, :]


def causal_short_conv(x, w, b):
    S = x.shape[1]
    xp = jnp.pad(x, ((0, 0), (CONV_WIDTH - 1, 0), (0, 0)))
    y = b
    for j in range(CONV_WIDTH):
        y = y + xp[:, j:j + S] * w[j]
    return y


def dilated_branch(q, k, v, window, dilation):
    B, S, H, Dh = q.shape
    n_back = window // dilation
    assert n_back <= ATTN_BLOCK and S % dilation == 0
    L = S // dilation
    nb = -(-L // ATTN_BLOCK)
    Lp = nb * ATTN_BLOCK

    def to_sub(t):
        t = t.reshape(B, L, dilation, H, Dh).transpose(0, 2, 1, 3, 4)
        t = jnp.pad(t, ((0, 0), (0, 0), (0, Lp - L), (0, 0), (0, 0)))
        return t.reshape(B, dilation, nb, ATTN_BLOCK, H, Dh)

    def with_prev(t):
        prev = jnp.pad(t, ((0, 0), (0, 0), (1, 0), (0, 0), (0, 0), (0, 0)))[:, :, :-1]
        return jnp.concatenate([prev, t], axis=3)

    qb = to_sub(q)
    kb = with_prev(to_sub(k))
    vb = with_prev(to_sub(v))
    s = jnp.einsum('brnqhd,brnkhd->brnhqk', qb, kb).astype(jnp.float32)
    qi = jnp.arange(ATTN_BLOCK)[:, None] + ATTN_BLOCK
    kj = jnp.arange(2 * ATTN_BLOCK)[None, :]
    rel = qi - kj
    band = (rel >= 0) & (rel <= n_back)
    valid = band[None] & ((jnp.arange(nb)[:, None, None] > 0) | (kj[None] >= ATTN_BLOCK))
    s = jnp.where(valid[None, None, :, None], s, -jnp.inf)
    lse = jax.nn.logsumexp(s, axis=-1)
    p = jnp.exp(s - lse[..., None])
    o = jnp.einsum('brnhqk,brnkhd->brnqhd', p.astype(v.dtype), vb)
    o = o.reshape(B, dilation, Lp, H, Dh)[:, :, :L]
    o = o.transpose(0, 2, 1, 3, 4).reshape(B, S, H, Dh)
    lse = lse.transpose(0, 1, 2, 4, 3).reshape(B, dilation, Lp, H)[:, :, :L]
    lse = lse.transpose(0, 2, 1, 3).reshape(B, S, H)
    return o, lse


def dilated_attention(q, k, v):
    outs, lses = [], []
    for window, dilation in DILATED_PATTERNS:
        o, lse = dilated_branch(q, k, v, window, dilation)
        outs.append(o)
        lses.append(lse)
    w = jax.nn.softmax(jnp.stack(lses, axis=0), axis=0)
    return jnp.einsum('pbsh,pbshd->bshd', w.astype(v.dtype), jnp.stack(outs, axis=0))


def mlstm_chunkwise(q, k, v, log_i, log_f):
    B, NH, S, D = q.shape
    L = MLSTM_CHUNK
    NC = S // L
    k = k * (D ** -0.5)

    def to_chunks(t):
        return jnp.moveaxis(t.reshape(B, NH, NC, L, *t.shape[3:]), 2, 0)

    xs = (to_chunks(q), to_chunks(k), to_chunks(v), to_chunks(log_i), to_chunks(log_f))
    causal = jnp.tril(jnp.ones((L, L), dtype=bool))

    def step(carry, inp):
        C, n, m = carry
        qc, kc, vc, ic, fc = inp
        b = jnp.cumsum(fc, axis=-1)
        log_d = b[..., :, None] - b[..., None, :] + ic[..., None, :]
        log_d = jnp.where(causal, log_d, -jnp.inf)
        m_inter = b + m[..., None]
        m_t = jnp.maximum(m_inter, jnp.max(log_d, axis=-1))
        d_mat = jnp.exp(log_d - m_t[..., None])
        inter = jnp.exp(m_inter - m_t)
        s_qk = jnp.einsum('bhtd,bhsd->bhts', qc, kc) * d_mat
        num = inter[..., None] * jnp.einsum('bhtd,bhde->bhte', qc, C) + jnp.einsum('bhts,bhse->bhte', s_qk, vc)
        nq = inter * jnp.einsum('bhtd,bhd->bht', qc, n) + jnp.sum(s_qk, axis=-1)
        h = num / jnp.maximum(jnp.abs(nq), jnp.exp(-m_t))[..., None]
        b_last = b[..., -1]
        w_log = b_last[..., None] - b + ic
        m_new = jnp.maximum(b_last + m, jnp.max(w_log, axis=-1))
        w = jnp.exp(w_log - m_new[..., None])
        decay = jnp.exp(b_last + m - m_new)
        C_new = decay[..., None, None] * C + jnp.einsum('bhs,bhsd,bhse->bhde', w, kc, vc)
        n_new = decay[..., None] * n + jnp.einsum('bhs,bhsd->bhd', w, kc)
        return (C_new, n_new, m_new), h

    init = (jnp.zeros((B, NH, D, D), jnp.float32),
            jnp.zeros((B, NH, D), jnp.float32),
            jnp.zeros((B, NH), jnp.float32))
    _, h = lax.scan(step, init, xs)
    return jnp.moveaxis(h, 0, 2).reshape(B, NH, S, D)


def token_mixer(h, w_in, w_conv, b_conv, b_igate, b_fgate, q_norm_g, k_norm_g, mlstm_norm_g, w_out):
    B, S, _ = h.shape
    xin = h @ w_in
    cuts = list(np.cumsum(IN_SPLITS)[:-1])
    qa, ka, va, qm, km, vm, og, ig, fg = jnp.split(xin, cuts, axis=-1)
    qa = rms_norm(qa.reshape(B, S, N_ATTN_HEADS, ATTN_HEAD_DIM), q_norm_g) * ATTN_SCALE
    ka = rms_norm(ka.reshape(B, S, N_ATTN_HEADS, ATTN_HEAD_DIM), k_norm_g)
    va = va.reshape(B, S, N_ATTN_HEADS, ATTN_HEAD_DIM)
    attn = dilated_attention(qa, ka, va).reshape(B, S, ATTN_WIDTH)
    qkm = jax.nn.silu(causal_short_conv(jnp.concatenate([qm, km], axis=-1), w_conv, b_conv))
    qm, km = jnp.split(qkm, 2, axis=-1)

    def heads(t):
        return t.reshape(B, S, N_MLSTM_HEADS, MLSTM_HEAD_DIM).transpose(0, 2, 1, 3).astype(jnp.float32)

    log_i = (ig + b_igate).astype(jnp.float32).transpose(0, 2, 1)
    log_f = jax.nn.log_sigmoid((fg + b_fgate).astype(jnp.float32)).transpose(0, 2, 1)
    hm = mlstm_chunkwise(heads(qm), heads(km), heads(vm), log_i, log_f)
    hm = hm.transpose(0, 2, 1, 3).astype(h.dtype)
    hm = rms_norm(hm, mlstm_norm_g.reshape(N_MLSTM_HEADS, MLSTM_HEAD_DIM)).reshape(B, S, MLSTM_WIDTH)
    hm = jax.nn.sigmoid(og) * hm
    return jnp.concatenate([attn, hm], axis=-1) @ w_out


def swiglu(h, w_gate, w_up, w_down):
    return (jax.nn.silu(h @ w_gate) * (h @ w_up)) @ w_down


def setup_inputs(seed: int = 0) -> dict:
    key = jax.random.key(seed)
    ks = jax.random.split(key, 20)
    f32 = jnp.float32
    D = D_MODEL

    def nrm(k, shape, scale):
        return jax.random.normal(k, shape, f32) * scale

    b_ada = nrm(ks[15], (DEPTH, N_MOD * D), 0.02)
    gate_cols = jnp.zeros((N_MOD, D), f32).at[2].set(1.0).at[5].set(1.0).reshape(-1)
    b_ada = b_ada + gate_cols
    f_bias = jnp.linspace(3.0, 6.0, N_MLSTM_HEADS, dtype=f32)[None, :]
    return {
        "x": nrm(ks[0], (BATCH, SEQ, D), 1.0),
        "c": nrm(ks[1], (BATCH, D), 1.0),
        "g_mix": 1.0 + nrm(ks[2], (DEPTH, D), 0.02),
        "w_in": nrm(ks[3], (DEPTH, D, IN_COLS), D ** -0.5),
        "w_conv": nrm(ks[4], (DEPTH, CONV_WIDTH, 2 * MLSTM_WIDTH), CONV_WIDTH ** -0.5),
        "b_conv": nrm(ks[5], (DEPTH, 2 * MLSTM_WIDTH), 0.02),
        "b_igate": nrm(ks[6], (DEPTH, N_MLSTM_HEADS), 0.1),
        "b_fgate": f_bias + nrm(ks[7], (DEPTH, N_MLSTM_HEADS), 0.1),
        "q_norm_g": 1.0 + nrm(ks[8], (DEPTH, ATTN_HEAD_DIM), 0.02),
        "k_norm_g": 1.0 + nrm(ks[9], (DEPTH, ATTN_HEAD_DIM), 0.02),
        "mlstm_norm_g": 1.0 + nrm(ks[10], (DEPTH, MLSTM_WIDTH), 0.02),
        "w_out": nrm(ks[11], (DEPTH, D, D), D ** -0.5),
        "g_ffn": 1.0 + nrm(ks[12], (DEPTH, D), 0.02),
        "w_gate": nrm(ks[13], (DEPTH, D, D_FF), D ** -0.5),
        "w_up": nrm(ks[14], (DEPTH, D, D_FF), D ** -0.5),
        "w_down": nrm(ks[16], (DEPTH, D_FF, D), D_FF ** -0.5),
        "w_ada": nrm(ks[17], (DEPTH, D, N_MOD * D), 0.1 * D ** -0.5),
        "b_ada": b_ada,
    }


def reference(x, c, g_mix, w_in, w_conv, b_conv, b_igate, b_fgate, q_norm_g, k_norm_g,
              mlstm_norm_g, w_out, g_ffn, w_gate, w_up, w_down, w_ada, b_ada):
    for l in range(DEPTH):
        mod = jax.nn.silu(c) @ w_ada[l] + b_ada[l]
        sh_m, sc_m, gt_m, sh_f, sc_f, gt_f = jnp.split(mod, N_MOD, axis=-1)
        h = modulate(rms_norm(x, g_mix[l]), sh_m, sc_m)
        y = token_mixer(h, w_in[l], w_conv[l], b_conv[l], b_igate[l], b_fgate[l],
                        q_norm_g[l], k_norm_g[l], mlstm_norm_g[l], w_out[l])
        x = x + gt_m[:, None, :] * y
        h = modulate(rms_norm(x, g_ffn[l]), sh_f, sc_f)
        x = x + gt_f[:, None, :] * swiglu(h, w_gate[l], w_up[l], w_down[l])
    return x
```

```cpp
#include <hip/hip_runtime.h>
#include <cstdio>
#include <cstdint>
namespace pg8 {
#define PG8_LAS __attribute__((address_space(3)))
typedef unsigned short bf16_t;
typedef short bf16x8 __attribute__((ext_vector_type(8)));
typedef float f32x4 __attribute__((ext_vector_type(4)));
typedef unsigned u32x4 __attribute__((ext_vector_type(4)));
constexpr int BM = 256, BK = 64, HALF = 128, HTB = HALF * BK * 2  , STAGE_BYTES = 8 * HTB, NXCD = 8, WGM = 8;

__host__ __device__ __forceinline__ int lds_byte(int r, int c) { const int st = (r >> 4) * 2 + (c >> 5), rr = r & 15, cc = c & 31, ob = rr * 64 + cc * 2; return st * 1024 + (ob ^ (((ob >> 9) & 1) << 5)); }
__host__ __device__ __forceinline__ void stage_rc(int b, int& R, int& C) { const int st = b / 1024, sb = b % 1024, swz = sb ^ (((sb >> 9) & 1) << 5); R = (st >> 1) * 16 + swz / 64; C = (st & 1) * 32 + (swz % 64) / 2; }
__host__ __device__ __forceinline__ int perm32(int rho) { const int n = rho >> 4, i = rho & 15; return 8 * (i >> 2) + 4 * n + (i & 3); }

struct Unit { int pm, pn; };
struct Gemm { const bf16_t* A; const bf16_t* Bt; int M, N, K; };

struct StaticOrder {
    int nM, nN, nwg, G, c;
    __host__ __device__ void init(int M, int N, int G_, int c_) { nM = M / BM; nN = N / BM; nwg = nM * nN; G = G_; c = c_; }
    __host__ __device__ bool next(int i, Unit& u) const {
        const long L = (long)i * G + c; if (L >= nwg) return false;
        int wgid = (int)L; { const int q = nwg / NXCD, r = nwg % NXCD, xcd = wgid % NXCD, off = wgid / NXCD; wgid = (xcd < r ? xcd * (q + 1) : r * (q + 1) + (xcd - r) * q) + off; }
        const int nig = WGM * nN, gid = wgid / nig, fm = gid * WGM, gsz = (nM - fm) < WGM ? (nM - fm) : WGM;
        u.pm = fm + ((wgid % nig) % gsz); u.pn = (wgid % nig) / gsz; return true;
    }
    __device__ __forceinline__ void a_ready(const Unit&) const {}
    __device__ __forceinline__ void done(const Unit&) const {}
};

__device__ __forceinline__ unsigned cvt_pk_bf16(float lo, float hi) { unsigned r; asm volatile("v_cvt_pk_bf16_f32 %0, %1, %2" : "=v"(r) : "v"(lo), "v"(hi)); return r; }
struct EpiBf16 {
    static constexpr bool PERM = true, AFTER_DRAIN = false;
    bf16_t* O; int ldc;
    __device__ __forceinline__ void operator()(const f32x4 (&acc)[2][2][4][2], const Unit& u, int wr, int wc, int fr, int fq) const {
        const int row0 = u.pm * BM + wr * 64 + fr; const int col0 = u.pn * BM + wc * 32 + 8 * fq;
#pragma unroll
        for (int ai = 0; ai < 2; ++ai)
#pragma unroll
            for (int m = 0; m < 4; ++m) { bf16_t* rowp = O + (size_t)(row0 + ai * HALF + m * 16) * ldc + col0;
#pragma unroll
                for (int bj = 0; bj < 2; ++bj) { const f32x4 v0 = acc[ai][bj][m][0], v1 = acc[ai][bj][m][1];
                    u32x4 w; w.x = cvt_pk_bf16(v0[0], v0[1]); w.y = cvt_pk_bf16(v0[2], v0[3]); w.z = cvt_pk_bf16(v1[0], v1[1]); w.w = cvt_pk_bf16(v1[2], v1[3]);
                    *(u32x4*)(rowp + bj * HALF) = w; } }
    }
};
__device__ __forceinline__ float silu_f(float x) { return x * __builtin_amdgcn_rcpf(1.0f + __builtin_amdgcn_exp2f(-1.44269504089f * x)); }
struct EpiSwiGLU {
    static constexpr bool PERM = true, AFTER_DRAIN = false;
    bf16_t* O; int ldc;
    __device__ __forceinline__ void operator()(const f32x4 (&acc)[2][2][4][2], const Unit& u, int wr, int wc, int fr, int fq) const {
        const int row0 = u.pm * BM + wr * 64 + fr; const int col0 = u.pn * HALF + wc * 32 + 8 * fq;
#pragma unroll
        for (int ai = 0; ai < 2; ++ai)
#pragma unroll
            for (int m = 0; m < 4; ++m) { bf16_t* rowp = O + (size_t)(row0 + ai * HALF + m * 16) * ldc + col0;
                const f32x4 g0 = acc[ai][0][m][0], g1 = acc[ai][0][m][1], u0 = acc[ai][1][m][0], u1 = acc[ai][1][m][1];
                u32x4 w; w.x = cvt_pk_bf16(silu_f(g0[0]) * u0[0], silu_f(g0[1]) * u0[1]); w.y = cvt_pk_bf16(silu_f(g0[2]) * u0[2], silu_f(g0[3]) * u0[3]);
                w.z = cvt_pk_bf16(silu_f(g1[0]) * u1[0], silu_f(g1[1]) * u1[1]); w.w = cvt_pk_bf16(silu_f(g1[2]) * u1[2], silu_f(g1[3]) * u1[3]);
                *(u32x4*)rowp = w; }
    }
};
struct EpiRes {
    static constexpr bool PERM = false, AFTER_DRAIN = false;
    const float* base; float* out; int ldc; const float* gate; int gate_stride; int rows_per_batch;
    __device__ __forceinline__ void operator()(const f32x4 (&acc)[2][2][4][2], const Unit& u, int wr, int wc, int fr, int fq) const {
        const int col0 = u.pn * BM + wc * 32 + 4 * fq; const int b = (u.pm * BM) / rows_per_batch;
        f32x4 gv[2][2];
#pragma unroll
        for (int bj = 0; bj < 2; ++bj)
#pragma unroll
            for (int n = 0; n < 2; ++n) gv[bj][n] = *(const f32x4*)(gate + (size_t)b * gate_stride + col0 + bj * HALF + n * 16);
#pragma unroll
        for (int ai = 0; ai < 2; ++ai)
#pragma unroll
            for (int m = 0; m < 4; ++m) { const size_t off = (size_t)(u.pm * BM + ai * HALF + wr * 64 + m * 16 + fr) * ldc + col0;
#pragma unroll
                for (int bj = 0; bj < 2; ++bj)
#pragma unroll
                    for (int n = 0; n < 2; ++n) { const f32x4 bs = *(const f32x4*)(base + off + bj * HALF + n * 16);
                        *(f32x4*)(out + off + bj * HALF + n * 16) = bs + gv[bj][n] * acc[ai][bj][m][n]; } }
    }
};
template <class Epi, class Sched, bool ALIGN_EPI = false, bool SP2 = false>
__device__ __forceinline__ void gemm_phase(PG8_LAS unsigned char* lds, const Gemm g, const Sched& S, const Epi& E) {
    const int tid = threadIdx.x, wid = __builtin_amdgcn_readfirstlane(tid >> 6), lane = tid & 63, wr = wid >> 2, wc = wid & 3, fr = lane & 15, fq = lane >> 4;
    const int K = g.K, nt = K / BK;
    unsigned voffA[2], voffB[2];
#pragma unroll
    for (int i = 0; i < 2; ++i) { int R, C; stage_rc(tid * 16 + i * 8192, R, C); const int Rb = Epi::PERM ? ((R & ~31) + perm32(R & 31)) : R;
        voffA[i] = (unsigned)(R * K + C) * 2u; voffB[i] = (unsigned)(Rb * K + C) * 2u; }
    const size_t kstep = (size_t)(BK * 2);
    const size_t hstep = (size_t)HALF * K * 2;
    const size_t tstep = 2 * hstep;
    const unsigned ldsw = (unsigned)wid * 1024u;
    const int aoff = lds_byte(wr * 64 + fr, fq * 8), boff = lds_byte(wc * 32 + fr, fq * 8);
#define PG8_SA(b, h) (((b) * 2 + (h)) * HTB)
#define PG8_SB(b, h) ((4 + (b) * 2 + (h)) * HTB)
#define PG8_STAGE(bufoff, gbase, voff) do { _Pragma("unroll") for (int _i = 0; _i < 2; ++_i) \
        __builtin_amdgcn_global_load_lds((const unsigned*)((const char*)(gbase) + (voff)[_i]), (PG8_LAS unsigned*)(lds + (bufoff) + ldsw + _i * 8192), 16, 0, 0); } while (0)
#define PG8_LDA(dst, b, h) do { _Pragma("unroll") for (int m = 0; m < 4; ++m) _Pragma("unroll") for (int k = 0; k < 2; ++k) dst[m][k] = *(const PG8_LAS bf16x8*)(lds + PG8_SA(b, h) + aoff + m * 2048 + k * 1024); } while (0)
#define PG8_LDB(dst, b, h) do { _Pragma("unroll") for (int n = 0; n < 2; ++n) _Pragma("unroll") for (int k = 0; k < 2; ++k) dst[n][k] = *(const PG8_LAS bf16x8*)(lds + PG8_SB(b, h) + boff + n * 2048 + k * 1024); } while (0)
#define PG8_MMA(ai, bj, At, Bt) do { __builtin_amdgcn_s_setprio(1); _Pragma("unroll") for (int m = 0; m < 4; ++m) _Pragma("unroll") for (int n = 0; n < 2; ++n) _Pragma("unroll") for (int k = 0; k < 2; ++k) \
        acc[ai][bj][m][n] = __builtin_amdgcn_mfma_f32_16x16x32_bf16(Bt[n][k], At[m][k], acc[ai][bj][m][n], 0, 0, 0); __builtin_amdgcn_s_setprio(0); } while (0)
#define PG8_WAIT_V(n) asm volatile("s_waitcnt vmcnt(" #n ")" ::: "memory")
#define PG8_WAIT_L(n) asm volatile("s_waitcnt lgkmcnt(" #n ")" ::: "memory")
#define PG8_BAR __builtin_amdgcn_s_barrier()
#define PG8_SCHED __builtin_amdgcn_sched_barrier(0)
    Unit cur, nxt; int ui = 0;
    if (!S.next(0, cur)) return;
    f32x4 acc[2][2][4][2];
#pragma unroll
    for (int a = 0; a < 2; ++a)
#pragma unroll
        for (int b = 0; b < 2; ++b)
#pragma unroll
            for (int m = 0; m < 4; ++m)
#pragma unroll
                for (int n = 0; n < 2; ++n) acc[a][b][m][n] = (f32x4){0.f, 0.f, 0.f, 0.f};
    bf16x8 At[4][2], B0[2][2], B1[2][2];
    const char* cA = (const char*)g.A + (size_t)cur.pm * tstep; const char* cB = (const char*)g.Bt + (size_t)cur.pn * tstep;
    S.a_ready(cur);
    if constexpr (SP2) {
        PG8_STAGE(PG8_SB(0, 0), cB, voffB); PG8_STAGE(PG8_SB(0, 1), cB + hstep, voffB); PG8_STAGE(PG8_SA(0, 0), cA, voffA); PG8_STAGE(PG8_SA(0, 1), cA + hstep, voffA);
        if (wr == 1) PG8_BAR;
        PG8_WAIT_V(2); PG8_BAR;
        PG8_STAGE(PG8_SB(1, 0), cB + kstep, voffB); PG8_STAGE(PG8_SA(1, 0), cA + kstep, voffA); PG8_STAGE(PG8_SB(1, 1), cB + hstep + kstep, voffB);
        PG8_WAIT_V(6); PG8_BAR;
    } else {
        PG8_STAGE(PG8_SB(0, 0), cB, voffB); PG8_STAGE(PG8_SA(0, 0), cA, voffA); PG8_STAGE(PG8_SB(0, 1), cB + hstep, voffB); PG8_STAGE(PG8_SA(0, 1), cA + hstep, voffA);
        if (wr == 1) PG8_BAR;
        PG8_WAIT_V(4); PG8_BAR;
        PG8_STAGE(PG8_SB(1, 0), cB + kstep, voffB); PG8_STAGE(PG8_SA(1, 0), cA + kstep, voffA); PG8_STAGE(PG8_SB(1, 1), cB + hstep + kstep, voffB);
        PG8_WAIT_V(6); PG8_BAR;
    }
    for (;;) {
        const bool has_next = S.next(ui + 1, nxt);
        const char* nA = has_next ? (const char*)g.A + (size_t)nxt.pm * tstep : cA; const char* nB = has_next ? (const char*)g.Bt + (size_t)nxt.pn * tstep : cB;
        for (int t = 0; t < nt; t += 2) {
            const bool last = (t == nt - 2);
            const char* a1 = cA + (size_t)(t + 1) * kstep;
            const char* a2 = last ? nA : cA + (size_t)(t + 2) * kstep; const char* b2 = last ? nB : cB + (size_t)(t + 2) * kstep;
            const char* a3 = a2 + kstep; const char* b3 = b2 + kstep;
            if (last && has_next) S.a_ready(nxt);
            if constexpr (SP2) {
            PG8_LDB(B0, 0, 0); PG8_LDB(B1, 0, 1); PG8_SCHED; PG8_LDA(At, 0, 0); PG8_STAGE(PG8_SA(1, 1), a1 + hstep, voffA);
            PG8_WAIT_V(8); PG8_WAIT_L(0); PG8_BAR; PG8_MMA(0, 0, At, B0); PG8_MMA(0, 1, At, B1); PG8_BAR; PG8_SCHED;
            PG8_LDA(At, 0, 1); PG8_STAGE(PG8_SB(0, 0), b2, voffB); PG8_STAGE(PG8_SB(0, 1), b2 + hstep, voffB); PG8_STAGE(PG8_SA(0, 0), a2, voffA);
            PG8_WAIT_V(8); PG8_WAIT_L(0); PG8_BAR; PG8_MMA(1, 0, At, B0); PG8_MMA(1, 1, At, B1); PG8_BAR; PG8_SCHED;
            PG8_LDB(B0, 1, 0); PG8_LDB(B1, 1, 1); PG8_SCHED; PG8_LDA(At, 1, 0); PG8_STAGE(PG8_SA(0, 1), a2 + hstep, voffA);
            PG8_WAIT_V(8); PG8_WAIT_L(0); PG8_BAR; PG8_MMA(0, 0, At, B0); PG8_MMA(0, 1, At, B1); PG8_BAR; PG8_SCHED;
            PG8_LDA(At, 1, 1); PG8_STAGE(PG8_SB(1, 0), b3, voffB); PG8_STAGE(PG8_SB(1, 1), b3 + hstep, voffB); PG8_STAGE(PG8_SA(1, 0), a3, voffA);
            PG8_WAIT_V(8); PG8_WAIT_L(0); PG8_BAR; PG8_MMA(1, 0, At, B0); PG8_MMA(1, 1, At, B1); PG8_BAR; PG8_SCHED;
            } else {
            PG8_LDB(B0, 0, 0); PG8_SCHED; PG8_LDA(At, 0, 0); PG8_STAGE(PG8_SA(1, 1), a1 + hstep, voffA);
            PG8_WAIT_L(8); PG8_BAR; PG8_WAIT_L(0); PG8_MMA(0, 0, At, B0); PG8_BAR; PG8_SCHED;
            PG8_LDB(B1, 0, 1); PG8_STAGE(PG8_SB(0, 0), b2, voffB);
            PG8_BAR; PG8_WAIT_L(0); PG8_MMA(0, 1, At, B1); PG8_BAR;
            PG8_LDA(At, 0, 1); PG8_STAGE(PG8_SA(0, 0), a2, voffA);
            PG8_BAR; PG8_WAIT_L(0); PG8_MMA(1, 0, At, B0); PG8_BAR; PG8_SCHED;
            PG8_STAGE(PG8_SB(0, 1), b2 + hstep, voffB);
            PG8_WAIT_V(6); PG8_BAR; PG8_MMA(1, 1, At, B1); PG8_BAR;
            PG8_LDB(B0, 1, 0); PG8_SCHED; PG8_LDA(At, 1, 0); PG8_STAGE(PG8_SA(0, 1), a2 + hstep, voffA);
            PG8_WAIT_L(8); PG8_BAR; PG8_WAIT_L(0); PG8_MMA(0, 0, At, B0); PG8_BAR; PG8_SCHED;
            PG8_LDB(B1, 1, 1); PG8_STAGE(PG8_SB(1, 0), b3, voffB);
            PG8_BAR; PG8_WAIT_L(0); PG8_MMA(0, 1, At, B1); PG8_BAR;
            PG8_LDA(At, 1, 1); PG8_STAGE(PG8_SA(1, 0), a3, voffA);
            PG8_BAR; PG8_WAIT_L(0); PG8_MMA(1, 0, At, B0); PG8_BAR; PG8_SCHED;
            PG8_STAGE(PG8_SB(1, 1), b3 + hstep, voffB);
            PG8_WAIT_V(6); PG8_BAR; PG8_MMA(1, 1, At, B1); PG8_BAR;
            }
        }
        if constexpr (ALIGN_EPI) { if (wr == 0) PG8_BAR; }
        if constexpr (!Epi::AFTER_DRAIN) { E(acc, cur, wr, wc, fr, fq); S.done(cur); }
        if (!has_next) break;
#pragma unroll
        for (int a = 0; a < 2; ++a)
#pragma unroll
            for (int b = 0; b < 2; ++b)
#pragma unroll
                for (int m = 0; m < 4; ++m)
#pragma unroll
                    for (int n = 0; n < 2; ++n) acc[a][b][m][n] = (f32x4){0.f, 0.f, 0.f, 0.f};
        cur = nxt; cA = nA; cB = nB; ++ui;
        if constexpr (ALIGN_EPI) { if (wr == 1) PG8_BAR; }
    }
    PG8_WAIT_V(0);
    if constexpr (!ALIGN_EPI) { if (wr == 0) PG8_BAR; }
    PG8_BAR;
    if constexpr (Epi::AFTER_DRAIN) { E.fused(acc, cur, wr, wc, fr, fq, lds, wid, lane); S.done(cur); }
#undef PG8_SA
#undef PG8_SB
#undef PG8_STAGE
#undef PG8_LDA
#undef PG8_LDB
#undef PG8_MMA
#undef PG8_WAIT_V
#undef PG8_WAIT_L
#undef PG8_BAR
#undef PG8_SCHED
}
}

constexpr int NWAVES = 8;
constexpr int BATCH = 2, SEQ = 8192, D = 1024, M = BATCH * SEQ;
constexpr int INC = 3592, NIN = 3584, FF = 2816, NGU = 2 * FF, NMOD = 6 * D;
constexpr int C_QA = 0, C_KA = 512, C_VA = 1024, C_QM = 1536, C_KM = 2048, C_VM = 2560, C_OG = 3072;
constexpr float RMS_EPS = 1e-6f;
constexpr size_t MiB = 1u << 20;
constexpr size_t WS_CTL = 0, CTL_ZERO_BYTES = 1 * MiB;
constexpr size_t WS_MOD = 1 * MiB;
constexpr size_t WS_GATES = 1 * MiB + 512 * 1024;
constexpr size_t WS_WIN = 2 * MiB, WS_WOUT = 9 * MiB, WS_WGU = 11 * MiB, WS_WDN = 22 * MiB;
constexpr size_t WS_STC = 28 * MiB, WS_STN = 44 * MiB, WS_STS = 44 * MiB + 512 * 1024;
constexpr size_t WS_XN = 48 * MiB;
constexpr size_t WS_CAT = 80 * MiB;
constexpr size_t WS_XIN = 112 * MiB;
constexpr size_t WS_H = 112 * MiB;
constexpr size_t WS_AUX = 224 * MiB;
constexpr size_t WS_END = 256 * MiB;
static_assert(WS_WDN + (size_t)D * FF * 2 <= WS_STC && WS_XIN + (size_t)M * NIN * 2 <= WS_AUX && WS_H + (size_t)M * FF * 2 <= WS_AUX, "ws map");
constexpr int CW_TMO = 0, CW_CODE = 1, CW_BAR = 4096;
constexpr int RING_OFF = 0, RING_BYTES = 131072;
constexpr int LDSCTL_OFF = RING_BYTES, MISC_OFF = LDSCTL_OFF + 320;
constexpr int LDS_BYTES = 147456;
#define GAS __attribute__((address_space(1)))
#define LAS __attribute__((address_space(3)))
typedef unsigned short bf16;
typedef unsigned v4u __attribute__((ext_vector_type(4)));
typedef unsigned v2u __attribute__((ext_vector_type(2)));
typedef float f32x4 __attribute__((ext_vector_type(4)));
typedef short bf16x8 __attribute__((ext_vector_type(8)));
typedef GAS unsigned gu32;
#define RLX_AGENT __ATOMIC_RELAXED, __HIP_MEMORY_SCOPE_AGENT
#define LDS_WAIT() asm volatile("s_waitcnt lgkmcnt(0)" ::: "memory")
#define VM_WAIT() asm volatile("s_waitcnt vmcnt(0)" ::: "memory")
__device__ __forceinline__ unsigned f2bf(float f) { unsigned u = __builtin_bit_cast(unsigned, f); return (u + 0x7fffu + ((u >> 16) & 1u)) >> 16; }
__device__ __forceinline__ unsigned pk2(float lo, float hi) { return f2bf(lo) | (f2bf(hi) << 16); }
__device__ __forceinline__ float bf2f(unsigned short u) { return __builtin_bit_cast(float, (unsigned)u << 16); }
__device__ __forceinline__ float bflo(unsigned w) { return __builtin_bit_cast(float, w << 16); }
__device__ __forceinline__ float bfhi(unsigned w) { return __builtin_bit_cast(float, w & 0xffff0000u); }
__device__ __forceinline__ float wave_sum(float v) {
#pragma unroll
    for (int o = 1; o < 64; o <<= 1) v += __shfl_xor(v, o);
    return v;
}
__device__ __forceinline__ float wave_max(float v) {
#pragma unroll
    for (int o = 1; o < 64; o <<= 1) v = fmaxf(v, __shfl_xor(v, o));
    return v;
}
__device__ __forceinline__ float silu(float x) { return x / (1.0f + __expf(-x)); }
__device__ __forceinline__ float sigmoidf_(float x) { return 1.0f / (1.0f + __expf(-x)); }
__device__ __forceinline__ float log_sigmoid(float z) { return fminf(z, 0.f) - log1pf(__expf(-fabsf(z))); }

#define XB_TMO      128
#define XB_XCNT(j)  (256  + 64 * (j))
#define XB_XSUB(j)  (1280 + 64 * (j))
#define XB_XGEN(j)  (2304 + 64 * (j))
#define XB_TOP      3328
#define XB_TOPGEN   3392
#define XCD_BAR_WORDS 3456
#define XB_SPIN_CAP (1u << 18)

__device__ __forceinline__ unsigned xb_ld(unsigned* p)              { return __hip_atomic_load(p, __ATOMIC_RELAXED, __HIP_MEMORY_SCOPE_AGENT); }
__device__ __forceinline__ unsigned xb_add(unsigned* p, unsigned v) { return __hip_atomic_fetch_add(p, v, __ATOMIC_RELAXED, __HIP_MEMORY_SCOPE_AGENT); }
__device__ __forceinline__ unsigned xb_xcc_id() { return (unsigned)__builtin_amdgcn_s_getreg((3 << 11) | 20) & 0xFu; }
#define XB_SPIN(cond, bar) do { unsigned _sp = 0; while (cond) { __builtin_amdgcn_s_sleep(1); \
    if ((++_sp & 255u) == 0u) { if (xb_ld(&(bar)[XB_TMO])) break; if (_sp > XB_SPIN_CAP) { atomicAdd(&(bar)[XB_TMO], 1u); break; } } } } while (0)

struct XcdBarrier {
    unsigned* bar; unsigned x;
    volatile LAS unsigned* st;
};

__device__ __forceinline__ XcdBarrier xcd_barrier_post(unsigned* bar, volatile LAS unsigned* st) {
    XcdBarrier b; b.bar = bar; b.x = xb_xcc_id(); b.st = st;
    if (threadIdx.x == 0) (void)xb_add(&bar[XB_XCNT(b.x)], 1u);
    return b;
}
__device__ __forceinline__ void xcd_barrier_complete(unsigned* bar, unsigned x, unsigned& nloc, unsigned& nx) {
    const unsigned G = gridDim.x * gridDim.y * gridDim.z;
    unsigned sum, cnt, mine, sp = 0u;
    for (;;) {
        sum = 0u; cnt = 0u; mine = 0u;
#pragma unroll
        for (unsigned j = 0; j < 16; ++j) { const unsigned c = xb_ld(&bar[XB_XCNT(j)]); sum += c; cnt += (c > 0u) ? 1u : 0u; mine = (j == x) ? c : mine; }
        if (sum == G) break;
        __builtin_amdgcn_s_sleep(1);
        if ((++sp & 255u) == 0u) { if (xb_ld(&bar[XB_TMO])) break; if (sp > XB_SPIN_CAP) { atomicAdd(&bar[XB_TMO], 1u); break; } }
    }
    nloc = mine > 0u ? mine : 1u; nx = cnt > 0u ? cnt : 1u;
}

__device__ __forceinline__ void xcd_barrier(const XcdBarrier& b) {
    asm volatile("s_waitcnt vmcnt(0)" ::: "memory");
    __syncthreads();
    if (threadIdx.x == 0) {
        unsigned* bar = b.bar;
        __builtin_amdgcn_s_waitcnt(0);
        unsigned nloc = b.st[0], nx = b.st[1];
        if (nloc == 0u) { xcd_barrier_complete(bar, b.x, nloc, nx); b.st[0] = nloc; b.st[1] = nx; }
        const unsigned old = xb_add(&bar[XB_XSUB(b.x)], 1u);
        const unsigned gen = old / nloc;
        if (old + 1u == (gen + 1u) * nloc) {
            __builtin_amdgcn_fence(__ATOMIC_RELEASE, "agent");
            asm volatile("s_waitcnt vmcnt(0)" ::: "memory");
            const unsigned og = xb_add(&bar[XB_TOP], 1u);
            const unsigned tg = og / nx;
            if (og + 1u == (tg + 1u) * nx) xb_add(&bar[XB_TOPGEN], 1u);
            else XB_SPIN(xb_ld(&bar[XB_TOPGEN]) == tg, bar);
            __builtin_amdgcn_fence(__ATOMIC_ACQUIRE, "agent");
            xb_add(&bar[XB_XGEN(b.x)], 1u);
            asm volatile("s_waitcnt vmcnt(0)" ::: "memory");
        } else {
            XB_SPIN(xb_ld(&bar[XB_XGEN(b.x)]) == gen, bar);
            __builtin_amdgcn_fence(__ATOMIC_ACQUIRE, "agent");
            asm volatile("s_waitcnt vmcnt(0)" ::: "memory");
        }
    }
    __syncthreads();
}
struct Frame {
    LAS unsigned char* lds; volatile LAS unsigned* MISC; gu32* ctl;
    int tid, lane, wave, vcu, G;
    const float *x, *c, *g_mix, *w_in, *w_conv, *b_conv, *b_ig, *b_fg, *qn_g, *kn_g, *mn_g, *w_out, *g_ffn, *w_gate, *w_up, *w_down, *w_ada, *b_ada;
    float* out; unsigned char* ws;
};

template <int MODE>
__device__ __forceinline__ void p0_transpose_item(const float* W, int K, int ldw, int nblk, bf16* WT, LAS float* scr, int item, int lane) {
    const int kb = item / nblk, nb = item % nblk, k0 = 64 * kb, n0 = 32 * nb;
#pragma unroll 8
    for (int i = 0; i < 32; ++i) { const int kk = 2 * i + (lane >> 5); scr[kk * 33 + (lane & 31)] = W[(size_t)(k0 + kk) * ldw + n0 + (lane & 31)]; }
    LDS_WAIT(); asm volatile("" ::: "memory");
    const int c = lane & 7;
#pragma unroll
    for (int j = 0; j < 4; ++j) { const int n = (lane >> 3) + 8 * j; const LAS float* s = scr + (8 * c) * 33 + n;
        v4u o; o.x = pk2(s[0 * 33], s[1 * 33]); o.y = pk2(s[2 * 33], s[3 * 33]); o.z = pk2(s[4 * 33], s[5 * 33]); o.w = pk2(s[6 * 33], s[7 * 33]);
        int row = n0 + n; if (MODE) row = ((row >> 7) << 8) + (row & 127) + (MODE == 2 ? 128 : 0);
        *(GAS v4u*)(WT + (size_t)row * K + k0 + 8 * c) = o; }
    LDS_WAIT(); asm volatile("" ::: "memory");
}
__device__ __forceinline__ void p0_prologue(Frame& F) {
    {
        LAS float* red = (LAS float*)(F.lds + RING_OFF);
        float* mod = (float*)(F.ws + WS_MOD);
        for (int cg = blockIdx.x; cg < 256; cg += F.G) {
            const int n0 = 24 * cg;
            float acc[2][24];
#pragma unroll
            for (int i = 0; i < 24; ++i) { acc[0][i] = 0.f; acc[1][i] = 0.f; }
            for (int k = F.tid; k < D; k += NWAVES * 64) {
                const float s0 = silu(F.c[k]), s1 = silu(F.c[D + k]);
                const f32x4* wr = (const f32x4*)(F.w_ada + (size_t)k * NMOD + n0);
#pragma unroll
                for (int i = 0; i < 6; ++i) { const f32x4 w = wr[i];
#pragma unroll
                    for (int e = 0; e < 4; ++e) { acc[0][4 * i + e] += s0 * w[e]; acc[1][4 * i + e] += s1 * w[e]; } }
            }
#pragma unroll
            for (int i = 0; i < 24; ++i) { acc[0][i] = wave_sum(acc[0][i]); acc[1][i] = wave_sum(acc[1][i]); }
            if (F.lane == 0) {
#pragma unroll
                for (int i = 0; i < 24; ++i) { red[F.wave * 48 + i] = acc[0][i]; red[F.wave * 48 + 24 + i] = acc[1][i]; } }
            __syncthreads();
            if (F.tid < 48) { float s = 0.f;
#pragma unroll
                for (int w = 0; w < NWAVES; ++w) s += red[w * 48 + F.tid];
                const int b = F.tid / 24, n = n0 + F.tid % 24; mod[b * NMOD + n] = s + F.b_ada[n]; }
            __syncthreads();
        }
    }
    LAS float* scr = (LAS float*)(F.lds + RING_OFF + F.wave * 16384);
    const int gw = F.vcu * NWAVES + F.wave, NGW = F.G * NWAVES;
    constexpr int I_IN = (D / 64) * (NIN / 32), I_OUT = (D / 64) * (D / 32), I_G = (D / 64) * (FF / 32), I_DN = (FF / 64) * (D / 32);
    constexpr int NITEMS = I_IN + I_OUT + 2 * I_G + I_DN;
    bf16* Win_t = (bf16*)(F.ws + WS_WIN); bf16* Wout_t = (bf16*)(F.ws + WS_WOUT); bf16* Wgu_t = (bf16*)(F.ws + WS_WGU); bf16* Wdn_t = (bf16*)(F.ws + WS_WDN);
    for (int it = gw; it < NITEMS; it += NGW) {
        int r = it;
        if (r < I_IN) { p0_transpose_item<0>(F.w_in, D, INC, NIN / 32, Win_t, scr, r, F.lane); continue; } r -= I_IN;
        if (r < I_OUT) { p0_transpose_item<0>(F.w_out, D, D, D / 32, Wout_t, scr, r, F.lane); continue; } r -= I_OUT;
        if (r < I_G) { p0_transpose_item<1>(F.w_gate, D, FF, FF / 32, Wgu_t, scr, r, F.lane); continue; } r -= I_G;
        if (r < I_G) { p0_transpose_item<2>(F.w_up, D, FF, FF / 32, Wgu_t, scr, r, F.lane); continue; } r -= I_G;
        p0_transpose_item<0>(F.w_down, FF, D, D / 32, Wdn_t, scr, r, F.lane);
    }
}
template <bool GATES>
__device__ __forceinline__ void norm_rows(Frame& F, const float* src, const float* g, const float* mshift, const float* mscale, bf16* XN, float* gates) {
    LAS float* gwl = (LAS float*)(F.lds + RING_OFF);
    if (GATES) {
        for (int i = F.tid; i < 8 * D; i += NWAVES * 64) { const int k = i >> 3, j = i & 7; gwl[j * D + k] = F.w_in[(size_t)k * INC + NIN + j]; }
        __syncthreads();
    }
    const int gw = F.vcu * NWAVES + F.wave, NGW = F.G * NWAVES;
    for (int m = gw; m < M; m += NGW) {
        const int b = m / SEQ;
        const GAS f32x4* xr = (const GAS f32x4*)(src + (size_t)m * D) + F.lane;
        f32x4 v[4]; float ss = 0.f;
#pragma unroll
        for (int j = 0; j < 4; ++j) { v[j] = xr[64 * j]; ss += (v[j].x * v[j].x + v[j].y * v[j].y) + (v[j].z * v[j].z + v[j].w * v[j].w); }
        const float rstd = 1.0f / sqrtf(wave_sum(ss) * (1.f / D) + RMS_EPS);
        float ga[8];
#pragma unroll
        for (int c = 0; c < 8; ++c) ga[c] = 0.f;
        GAS unsigned long long* o8 = (GAS unsigned long long*)(XN + (size_t)m * D) + F.lane;
#pragma unroll
        for (int j = 0; j < 4; ++j) {
            const int k0 = 256 * j + 4 * F.lane;
            const f32x4 g4 = *(const f32x4*)(g + k0), sc4 = *(const f32x4*)(mscale + (size_t)b * NMOD + k0), sh4 = *(const f32x4*)(mshift + (size_t)b * NMOD + k0);
            const f32x4 h = (v[j] * rstd) * g4 * (sc4 + 1.0f) + sh4;
            o8[64 * j] = (unsigned long long)pk2(h.x, h.y) | ((unsigned long long)pk2(h.z, h.w) << 32);
            if (GATES) {
#pragma unroll
                for (int c = 0; c < 8; ++c) { const f32x4 w4 = *(const LAS f32x4*)(gwl + c * D + k0); ga[c] += (h.x * w4.x + h.y * w4.y) + (h.z * w4.z + h.w * w4.w); }
            }
        }
        if (GATES) {
#pragma unroll
            for (int c = 0; c < 8; ++c) ga[c] = wave_sum(ga[c]);
            if (F.lane == 0) {
#pragma unroll
                for (int c = 0; c < 4; ++c) { gates[(size_t)m * 8 + c] = ga[c] + F.b_ig[c]; gates[(size_t)m * 8 + 4 + c] = log_sigmoid(ga[4 + c] + F.b_fg[c]); }
            }
        }
    }
}
__global__ void __launch_bounds__(256) nv_conv(const bf16* XIN, const float* w_conv, const float* b_conv, bf16* QKc) {
    const size_t idx = (size_t)blockIdx.x * 256 + threadIdx.x;
    const int m = (int)(idx >> 10), c = (int)(idx & 1023), t = m & (SEQ - 1);
    float y = b_conv[c];
#pragma unroll
    for (int j = 0; j < 4; ++j) { const int tt = t - 3 + j; if (tt >= 0) y += w_conv[j * 1024 + c] * bf2f(XIN[(size_t)(m - 3 + j) * NIN + C_QM + c]); }
    y = silu(y); if (c >= 512) y *= 0.08838834764831845f;
    QKc[idx] = (bf16)f2bf(y);
}
__global__ void __launch_bounds__(256) nv_attn(const bf16* XIN, const float* qg, const float* kg, bf16* CAT) {
    __shared__ float pl[4][448]; __shared__ float qs[4][64];
    const int wave = threadIdx.x >> 6, lane = threadIdx.x & 63;
    const int idx = blockIdx.x * 4 + wave; const int m = idx >> 3, h = idx & 7; const int b = m >> 13, t = m & (SEQ - 1);
    const float qv = bf2f(XIN[(size_t)m * NIN + C_QA + h * 64 + lane]);
    const float ssq = wave_sum(qv * qv);
    qs[wave][lane] = qv * (1.0f / sqrtf(ssq * (1.f / 64) + RMS_EPS)) * qg[lane] * 0.125f * kg[lane];
    __syncthreads();
    float sc[7]; float mx = -INFINITY;
#pragma unroll
    for (int i = 0; i < 7; ++i) {
        const int kk = lane + 64 * i; float s = -INFINITY;
        if (kk < 387) { const int p = kk / 129, j = kk - 129 * p; const int pos = t - (j << (2 * p));
            if (pos >= 0) { const v4u* kr = (const v4u*)(XIN + (size_t)(b * SEQ + pos) * NIN + C_KA + h * 64); float dot = 0.f, ssk = 0.f;
#pragma unroll
                for (int c = 0; c < 8; ++c) { const v4u w = kr[c];
#pragma unroll
                    for (int e = 0; e < 4; ++e) { const float k0 = bflo(w[e]), k1 = bfhi(w[e]); dot += qs[wave][8 * c + 2 * e] * k0 + qs[wave][8 * c + 2 * e + 1] * k1; ssk += k0 * k0 + k1 * k1; } }
                s = dot / sqrtf(ssk * (1.f / 64) + RMS_EPS); } }
        sc[i] = s; mx = fmaxf(mx, s);
    }
    mx = wave_max(mx);
    float l = 0.f;
#pragma unroll
    for (int i = 0; i < 7; ++i) { const float p = (sc[i] == -INFINITY) ? 0.f : __expf(sc[i] - mx); pl[wave][lane + 64 * i] = p; l += p; }
    l = wave_sum(l);
    __syncthreads();
    float o = 0.f;
    for (int kk = 0; kk < 387; ++kk) { const float pw = pl[wave][kk];
        if (pw != 0.f) { const int p = kk / 129, j = kk - 129 * p; const int pos = t - (j << (2 * p)); o += pw * bf2f(XIN[(size_t)(b * SEQ + pos) * NIN + C_VA + h * 64 + lane]); } }
    CAT[(size_t)m * 1024 + h * 64 + lane] = (bf16)f2bf(o / l);
}
__global__ void __launch_bounds__(64) nv_mlstm(const bf16* XIN, const bf16* QKc, const float* gates, float* NUM, float* NQ, float* MT) {
    const int bh = blockIdx.x / 3, cg = blockIdx.x % 3; const int b = bh >> 2, h = bh & 3; const int e = cg * 64 + (int)threadIdx.x;
    if (e > 128) return;
    float C[128];
#pragma unroll
    for (int d = 0; d < 128; ++d) C[d] = 0.f;
    float mprev = 0.f;
    for (int t = 0; t < SEQ; ++t) {
        const size_t m = (size_t)b * SEQ + t;
        const float li = gates[m * 8 + h], lf = gates[m * 8 + 4 + h];
        const float mn = fmaxf(lf + mprev, li); const float fs = __expf(lf + mprev - mn), is = __expf(li - mn); mprev = mn;
        const float ve = e < 128 ? bf2f(XIN[m * NIN + C_VM + h * 128 + e]) : 1.f; const float iv = is * ve;
        const bf16* qr = QKc + m * 1024 + h * 128; const bf16* kr = QKc + m * 1024 + 512 + h * 128;
        float dot = 0.f;
#pragma unroll
        for (int d = 0; d < 128; ++d) { C[d] = fs * C[d] + iv * bf2f(kr[d]); dot += C[d] * bf2f(qr[d]); }
        if (e < 128) NUM[m * 512 + h * 128 + e] = dot; else { NQ[m * 4 + h] = dot; MT[m * 4 + h] = mn; }
    }
}
__global__ void __launch_bounds__(256) nv_final(const bf16* XIN, const float* NUM, const float* NQ, const float* MT, const float* mn_g, bf16* CAT) {
    const int wave = threadIdx.x >> 6, lane = threadIdx.x & 63;
    const int idx = blockIdx.x * 4 + wave; const size_t m = idx >> 2; const int h = idx & 3;
    const float den = fmaxf(fabsf(NQ[m * 4 + h]), __expf(-MT[m * 4 + h]));
    const float h0 = NUM[m * 512 + h * 128 + lane] / den, h1 = NUM[m * 512 + h * 128 + 64 + lane] / den;
    const float r = 1.0f / sqrtf(wave_sum(h0 * h0 + h1 * h1) * (1.f / 128) + RMS_EPS);
    const float o0 = bf2f(XIN[m * NIN + C_OG + h * 128 + lane]), o1 = bf2f(XIN[m * NIN + C_OG + h * 128 + 64 + lane]);
    CAT[m * 1024 + 512 + h * 128 + lane] = (bf16)f2bf(h0 * r * mn_g[h * 128 + lane] * sigmoidf_(o0));
    CAT[m * 1024 + 512 + h * 128 + 64 + lane] = (bf16)f2bf(h1 * r * mn_g[h * 128 + 64 + lane] * sigmoidf_(o1));
}
struct Args { const float* in[18]; float* out; unsigned char* ws; int ph_lo, ph_hi, li, pad; };
__global__ void __launch_bounds__(NWAVES * 64, 2) blk_fwd(Args args) {
    extern __shared__ __attribute__((aligned(16))) unsigned char lds[];
    Frame F;
    F.lds = (LAS unsigned char*)lds;
    F.MISC = (volatile LAS unsigned*)(F.lds + MISC_OFF);
    F.tid = threadIdx.x; F.lane = F.tid & 63; F.wave = __builtin_amdgcn_readfirstlane(F.tid >> 6);
    F.G = gridDim.x; { const int bx = blockIdx.x; F.vcu = (F.G % 8 == 0) ? (bx % 8) * (F.G / 8) + bx / 8 : bx; }
    unsigned char* ws = args.ws; F.ws = ws;
    F.ctl = (gu32*)(ws + WS_CTL);
    F.x = args.in[0]; F.c = args.in[1]; F.g_mix = args.in[2]; F.w_in = args.in[3]; F.w_conv = args.in[4]; F.b_conv = args.in[5]; F.b_ig = args.in[6]; F.b_fg = args.in[7];
    F.qn_g = args.in[8]; F.kn_g = args.in[9]; F.mn_g = args.in[10]; F.w_out = args.in[11]; F.g_ffn = args.in[12]; F.w_gate = args.in[13]; F.w_up = args.in[14]; F.w_down = args.in[15];
    F.w_ada = args.in[16]; F.b_ada = args.in[17]; F.out = args.out;
    for (int u = F.tid; u < (LDS_BYTES - LDSCTL_OFF) / 4; u += NWAVES * 64) ((LAS unsigned*)(F.lds + LDSCTL_OFF))[u] = 0u;
    __syncthreads();
    const int lo = args.ph_lo, hi = args.ph_hi;
    XcdBarrier bar; bar.bar = (unsigned*)(F.ctl + CW_BAR) + args.li * XCD_BAR_WORDS; bar.x = 0; bar.st = nullptr;
    if (hi - lo > 1) bar = xcd_barrier_post((unsigned*)(F.ctl + CW_BAR) + args.li * XCD_BAR_WORDS, F.MISC + 8);
#define IN(k) (lo <= (k) && (k) < hi)
#define BOTH(k) (IN(k) && IN((k) + 1))
#define GRID_BAR() xcd_barrier(bar)
    bf16* Win_t = (bf16*)(ws + WS_WIN); bf16* Wout_t = (bf16*)(ws + WS_WOUT); bf16* Wgu_t = (bf16*)(ws + WS_WGU); bf16* Wdn_t = (bf16*)(ws + WS_WDN);
    bf16* XN = (bf16*)(ws + WS_XN); bf16* XIN = (bf16*)(ws + WS_XIN); bf16* CAT = (bf16*)(ws + WS_CAT); bf16* HB = (bf16*)(ws + WS_H);
    float* mod = (float*)(ws + WS_MOD); float* gates = (float*)(ws + WS_GATES);

    if (IN(0)) { p0_prologue(F); if (BOTH(0)) GRID_BAR(); }
    if (IN(1)) { norm_rows<true>(F, F.x, F.g_mix, mod + 0 * D, mod + 1 * D, XN, gates); if (BOTH(1)) GRID_BAR(); }
    if (IN(2)) {
        pg8::Gemm g{XN, Win_t, M, NIN, D}; pg8::StaticOrder S; S.init(M, NIN, F.G, (int)blockIdx.x);
        pg8::EpiBf16 E{XIN, NIN};
        pg8::gemm_phase<pg8::EpiBf16, pg8::StaticOrder, true, true>(F.lds + RING_OFF, g, S, E);
        if (BOTH(2)) GRID_BAR();
    }
    if (IN(3)) { if (BOTH(3)) GRID_BAR(); }
    if (IN(4)) {
        pg8::Gemm g{CAT, Wout_t, M, D, D}; pg8::StaticOrder S; S.init(M, D, F.G, (int)blockIdx.x);
        pg8::EpiRes E{F.x, F.out, D, mod + 2 * D, NMOD, SEQ};
        pg8::gemm_phase<pg8::EpiRes, pg8::StaticOrder, true, true>(F.lds + RING_OFF, g, S, E);
        if (BOTH(4)) GRID_BAR();
    }
    if (IN(5)) { norm_rows<false>(F, F.out, F.g_ffn, mod + 3 * D, mod + 4 * D, XN, nullptr); if (BOTH(5)) GRID_BAR(); }
    if (IN(6)) {
        pg8::Gemm g{XN, Wgu_t, M, NGU, D}; pg8::StaticOrder S; S.init(M, NGU, F.G, (int)blockIdx.x);
        pg8::EpiSwiGLU E{HB, FF};
        pg8::gemm_phase<pg8::EpiSwiGLU, pg8::StaticOrder, true, true>(F.lds + RING_OFF, g, S, E);
        if (BOTH(6)) GRID_BAR();
    }
    if (IN(7)) {
        pg8::Gemm g{HB, Wdn_t, M, D, FF}; pg8::StaticOrder S; S.init(M, D, F.G, (int)blockIdx.x);
        pg8::EpiRes E{F.out, F.out, D, mod + 5 * D, NMOD, SEQ};
        pg8::gemm_phase<pg8::EpiRes, pg8::StaticOrder, true, true>(F.lds + RING_OFF, g, S, E);
    }
#undef IN
#undef BOTH
}

extern "C" void kernel_launch(void* const* d_in, const int* in_sizes, int n_in, void* d_out, int out_size, void* d_ws, size_t ws_size, hipStream_t stream) {
    static int grid = 0;
    if (grid == 0) {
        if (n_in != 18 || out_size != M * D || ws_size < WS_END) { fprintf(stderr, "kernel_launch: unexpected shapes n_in %d out %d ws %zu\n", n_in, out_size, ws_size); grid = -1; return; }
        int dev = 0, cus = 0;
        if (hipGetDevice(&dev) != hipSuccess || hipDeviceGetAttribute(&cus, hipDeviceAttributeMultiprocessorCount, dev) != hipSuccess) { grid = -1; return; }
        if (hipFuncSetAttribute((const void*)blk_fwd, hipFuncAttributeMaxDynamicSharedMemorySize, LDS_BYTES) != hipSuccess) { fprintf(stderr, "kernel_launch: hipFuncSetAttribute failed\n"); grid = -1; return; }
        grid = cus;
    }
    if (grid < 0) return;
    (void)hipMemsetAsync((char*)d_ws + WS_CTL, 0, CTL_ZERO_BYTES, stream);
    Args a{};
    for (int i = 0; i < 18; ++i) a.in[i] = (const float*)d_in[i];
    a.out = (float*)d_out; a.ws = (unsigned char*)d_ws;
    unsigned char* ws = (unsigned char*)d_ws;
    int li = 0;
    auto run = [&](int lo, int hi) { a.ph_lo = lo; a.ph_hi = hi; a.li = li++; hipLaunchKernelGGL(blk_fwd, dim3(grid), dim3(NWAVES * 64), LDS_BYTES, stream, a); };
    run(0, 1); run(1, 2); run(2, 3);
    {
        const bf16* XIN = (const bf16*)(ws + WS_XIN); bf16* QKc = (bf16*)(ws + WS_XN); bf16* CAT = (bf16*)(ws + WS_CAT);
        float* NUM = (float*)d_out; float* NQ = (float*)(ws + WS_AUX); float* MT = (float*)(ws + WS_AUX + 1 * MiB);
        hipLaunchKernelGGL(nv_conv, dim3(M * 1024 / 256), dim3(256), 0, stream, XIN, (const float*)d_in[4], (const float*)d_in[5], QKc);
        hipLaunchKernelGGL(nv_attn, dim3(M * 8 / 4), dim3(256), 0, stream, XIN, (const float*)d_in[8], (const float*)d_in[9], CAT);
        hipLaunchKernelGGL(nv_mlstm, dim3(24), dim3(64), 0, stream, XIN, (const bf16*)QKc, (const float*)(ws + WS_GATES), NUM, NQ, MT);
        hipLaunchKernelGGL(nv_final, dim3(M * 4 / 4), dim3(256), 0, stream, XIN, (const float*)NUM, (const float*)NQ, (const float*)MT, (const float*)d_in[10], CAT);
    }
    run(4, 5); run(5, 6); run(6, 7); run(7, 8);
}
```

```cpp
#include <hip/hip_runtime.h>
#include <cstdio>
#include <cstdint>

namespace pg8 {
#define PG8_LAS __attribute__((address_space(3)))
typedef unsigned short bf16_t;
typedef short bf16x8 __attribute__((ext_vector_type(8)));
typedef float f32x4 __attribute__((ext_vector_type(4)));
typedef unsigned u32x4 __attribute__((ext_vector_type(4)));
constexpr int BM = 256, BK = 64, HALF = 128, HTB = HALF * BK * 2  , STAGE_BYTES = 8 * HTB, NXCD = 8, WGM = 8;

__host__ __device__ __forceinline__ int lds_byte(int r, int c) { const int st = (r >> 4) * 2 + (c >> 5), rr = r & 15, cc = c & 31, ob = rr * 64 + cc * 2; return st * 1024 + (ob ^ (((ob >> 9) & 1) << 5)); }
__host__ __device__ __forceinline__ void stage_rc(int b, int& R, int& C) { const int st = b / 1024, sb = b % 1024, swz = sb ^ (((sb >> 9) & 1) << 5); R = (st >> 1) * 16 + swz / 64; C = (st & 1) * 32 + (swz % 64) / 2; }
__host__ __device__ __forceinline__ int perm32(int rho) { const int n = rho >> 4, i = rho & 15; return 8 * (i >> 2) + 4 * n + (i & 3); }

struct Unit { int pm, pn, half; };
struct Gemm { const bf16_t* A; const bf16_t* Bt; int M, N, K; };

struct StaticOrder {
    int nM, nN, nwg, G, c; bool half_tail;
    __host__ __device__ void init(int M, int N, int G_, int c_, bool half_tail_ = false) { nM = M / BM; nN = N / BM; nwg = nM * nN; G = G_; c = c_; half_tail = half_tail_ && (nwg % G_) * 2 == G_; }
    __host__ __device__ bool next(int i, Unit& u) const {
        long L = (long)i * G + c; u.half = -1;
        if (half_tail && L >= (long)(nwg / G) * G) { if (i > nwg / G) return false; L = (long)(nwg / G) * G + (c >> 1); u.half = c & 1; }
        if (L >= nwg) return false;
        int wgid = (int)L; { const int q = nwg / NXCD, r = nwg % NXCD, xcd = wgid % NXCD, off = wgid / NXCD; wgid = (xcd < r ? xcd * (q + 1) : r * (q + 1) + (xcd - r) * q) + off; }
        const int nig = WGM * nN, gid = wgid / nig, fm = gid * WGM, gsz = (nM - fm) < WGM ? (nM - fm) : WGM;
        u.pm = fm + ((wgid % nig) % gsz); u.pn = (wgid % nig) / gsz; return true;
    }
    __device__ __forceinline__ void a_ready(const Unit&) const {}
    __device__ __forceinline__ void done(const Unit&) const {}
};

__device__ __forceinline__ unsigned cvt_pk_bf16(float lo, float hi) { unsigned r; asm volatile("v_cvt_pk_bf16_f32 %0, %1, %2" : "=v"(r) : "v"(lo), "v"(hi)); return r; }
typedef float f32x2 __attribute__((ext_vector_type(2)));
struct EpiBf16 {
    static constexpr bool PERM = true, AFTER_DRAIN = false;
    bf16_t* O; int ldc; unsigned obytes;
    __device__ __forceinline__ void operator()(const f32x4 (&acc)[2][2][4][2], const Unit& u, int wr, int wc, int fr, int fq) const {
        const int row0 = u.pm * BM + wr * 64 + fr; const int col0 = u.pn * BM + wc * 32 + 8 * fq;
        const __amdgpu_buffer_rsrc_t rs = __builtin_amdgcn_make_buffer_rsrc(O, 0, obytes, 0x00020000);
#pragma unroll
        for (int ai = 0; ai < 2; ++ai)
#pragma unroll
            for (int m = 0; m < 4; ++m) { const unsigned voff = (unsigned)(((size_t)(row0 + ai * HALF + m * 16) * ldc + col0) * 2);
#pragma unroll
                for (int bj = 0; bj < 2; ++bj) { const f32x4 v0 = acc[ai][bj][m][0], v1 = acc[ai][bj][m][1];
                    u32x4 w; w.x = cvt_pk_bf16(v0[0], v0[1]); w.y = cvt_pk_bf16(v0[2], v0[3]); w.z = cvt_pk_bf16(v1[0], v1[1]); w.w = cvt_pk_bf16(v1[2], v1[3]);
                    __builtin_amdgcn_raw_buffer_store_b128(w, rs, voff + bj * HALF * 2, 0, 16); } }
    }
};
__device__ __forceinline__ float silu_f(float x) { return x * __builtin_amdgcn_rcpf(1.0f + __builtin_amdgcn_exp2f(-1.44269504089f * x)); }
struct EpiSwiGLU {
    static constexpr bool PERM = true, AFTER_DRAIN = false;
    bf16_t* O; int ldc; unsigned obytes;
    __device__ __forceinline__ void operator()(const f32x4 (&acc)[2][2][4][2], const Unit& u, int wr, int wc, int fr, int fq) const {
        const int row0 = u.pm * BM + (u.half > 0 ? HALF : 0) + wr * 64 + fr; const int col0 = u.pn * HALF + wc * 32 + 8 * fq;
        const __amdgpu_buffer_rsrc_t rs = __builtin_amdgcn_make_buffer_rsrc(O, 0, obytes, 0x00020000);
#pragma unroll
        for (int ai = 0; ai < 2; ++ai) { if (ai == 1 && u.half >= 0) break;
#pragma unroll
            for (int m = 0; m < 4; ++m) { const unsigned voff = (unsigned)(((size_t)(row0 + ai * HALF + m * 16) * ldc + col0) * 2);
                const f32x4 g0 = acc[ai][0][m][0], g1 = acc[ai][0][m][1], u0 = acc[ai][1][m][0], u1 = acc[ai][1][m][1];
                u32x4 w; w.x = cvt_pk_bf16(silu_f(g0[0]) * u0[0], silu_f(g0[1]) * u0[1]); w.y = cvt_pk_bf16(silu_f(g0[2]) * u0[2], silu_f(g0[3]) * u0[3]);
                w.z = cvt_pk_bf16(silu_f(g1[0]) * u1[0], silu_f(g1[1]) * u1[1]); w.w = cvt_pk_bf16(silu_f(g1[2]) * u1[2], silu_f(g1[3]) * u1[3]);
                __builtin_amdgcn_raw_buffer_store_b128(w, rs, voff, 0, 16); } }
    }
};
template <class Epi, class Sched, bool ALIGN_EPI = false, bool SP2 = false>
__device__ __forceinline__ void gemm_phase(PG8_LAS unsigned char* lds, const Gemm g, const Sched& S, const Epi& E) {
    const int tid = threadIdx.x, wid = __builtin_amdgcn_readfirstlane(tid >> 6), lane = tid & 63, wr = wid >> 2, wc = wid & 3, fr = lane & 15, fq = lane >> 4;
    const int K = g.K, nt = K / BK;
    unsigned voffA[2], voffB[2];
#pragma unroll
    for (int i = 0; i < 2; ++i) { int R, C; stage_rc(tid * 16 + i * 8192, R, C); const int Rb = Epi::PERM ? ((R & ~31) + perm32(R & 31)) : R;
        voffA[i] = (unsigned)(R * K + C) * 2u; voffB[i] = (unsigned)(Rb * K + C) * 2u; }
    const size_t kstep = (size_t)(BK * 2);
    const size_t hstep = (size_t)HALF * K * 2;
    const size_t tstep = 2 * hstep;
    const unsigned ldsw = (unsigned)wid * 1024u;
    const int aoff = lds_byte(wr * 64 + fr, fq * 8), boff = lds_byte(wc * 32 + fr, fq * 8);
#define PG8_SA(b, h) (((b) * 2 + (h)) * HTB)
#define PG8_SB(b, h) ((4 + (b) * 2 + (h)) * HTB)
#define PG8_STAGE(bufoff, gbase, voff) do { _Pragma("unroll") for (int _i = 0; _i < 2; ++_i) \
        __builtin_amdgcn_global_load_lds((const unsigned*)((const char*)(gbase) + (voff)[_i]), (PG8_LAS unsigned*)(lds + (bufoff) + ldsw + _i * 8192), 16, 0, 0); } while (0)
#define PG8_LDA(dst, b, h) do { _Pragma("unroll") for (int m = 0; m < 4; ++m) _Pragma("unroll") for (int k = 0; k < 2; ++k) dst[m][k] = *(const PG8_LAS bf16x8*)(lds + PG8_SA(b, h) + aoff + m * 2048 + k * 1024); } while (0)
#define PG8_LDB(dst, b, h) do { _Pragma("unroll") for (int n = 0; n < 2; ++n) _Pragma("unroll") for (int k = 0; k < 2; ++k) dst[n][k] = *(const PG8_LAS bf16x8*)(lds + PG8_SB(b, h) + boff + n * 2048 + k * 1024); } while (0)
#define PG8_MMA(ai, bj, At, Bt) do { __builtin_amdgcn_s_setprio(1); _Pragma("unroll") for (int m = 0; m < 4; ++m) _Pragma("unroll") for (int n = 0; n < 2; ++n) _Pragma("unroll") for (int k = 0; k < 2; ++k) \
        acc[ai][bj][m][n] = __builtin_amdgcn_mfma_f32_16x16x32_bf16(Bt[n][k], At[m][k], acc[ai][bj][m][n], 0, 0, 0); __builtin_amdgcn_s_setprio(0); } while (0)
#define PG8_WAIT_V(n) asm volatile("s_waitcnt vmcnt(" #n ")" ::: "memory")
#define PG8_WAIT_L(n) asm volatile("s_waitcnt lgkmcnt(" #n ")" ::: "memory")
#define PG8_BAR __builtin_amdgcn_s_barrier()
#define PG8_SCHED __builtin_amdgcn_sched_barrier(0)
    Unit cur, nxt; int ui = 0;
    if (!S.next(0, cur)) return;
    f32x4 acc[2][2][4][2];
#pragma unroll
    for (int a = 0; a < 2; ++a)
#pragma unroll
        for (int b = 0; b < 2; ++b)
#pragma unroll
            for (int m = 0; m < 4; ++m)
#pragma unroll
                for (int n = 0; n < 2; ++n) acc[a][b][m][n] = (f32x4){0.f, 0.f, 0.f, 0.f};
    bf16x8 At[4][2], B0[2][2], B1[2][2];
    const char* cA = (const char*)g.A + (size_t)cur.pm * tstep + (cur.half > 0 ? hstep : 0); const char* cB = (const char*)g.Bt + (size_t)cur.pn * tstep;
    size_t hsAc = cur.half >= 0 ? 0 : hstep;
    S.a_ready(cur);
    if constexpr (SP2) {
        PG8_STAGE(PG8_SB(0, 0), cB, voffB); PG8_STAGE(PG8_SB(0, 1), cB + hstep, voffB); PG8_STAGE(PG8_SA(0, 0), cA, voffA); PG8_STAGE(PG8_SA(0, 1), cA + hsAc, voffA);
        if (wr == 1) PG8_BAR;
        PG8_WAIT_V(2); PG8_BAR;
        PG8_STAGE(PG8_SB(1, 0), cB + kstep, voffB); PG8_STAGE(PG8_SA(1, 0), cA + kstep, voffA); PG8_STAGE(PG8_SB(1, 1), cB + hstep + kstep, voffB);
        PG8_WAIT_V(6); PG8_BAR;
    } else {
        PG8_STAGE(PG8_SB(0, 0), cB, voffB); PG8_STAGE(PG8_SA(0, 0), cA, voffA); PG8_STAGE(PG8_SB(0, 1), cB + hstep, voffB); PG8_STAGE(PG8_SA(0, 1), cA + hstep, voffA);
        if (wr == 1) PG8_BAR;
        PG8_WAIT_V(4); PG8_BAR;
        PG8_STAGE(PG8_SB(1, 0), cB + kstep, voffB); PG8_STAGE(PG8_SA(1, 0), cA + kstep, voffA); PG8_STAGE(PG8_SB(1, 1), cB + hstep + kstep, voffB);
        PG8_WAIT_V(6); PG8_BAR;
    }
    for (;;) {
        const bool has_next = S.next(ui + 1, nxt);
        const char* nA = has_next ? (const char*)g.A + (size_t)nxt.pm * tstep + (nxt.half > 0 ? hstep : 0) : cA; const char* nB = has_next ? (const char*)g.Bt + (size_t)nxt.pn * tstep : cB;
        const size_t hsAn = has_next ? (nxt.half >= 0 ? 0 : hstep) : hsAc; const bool full = cur.half < 0;
        for (int t = 0; t < nt; t += 2) {
            const bool last = (t == nt - 2);
            const char* a1 = cA + (size_t)(t + 1) * kstep;
            const char* a2 = last ? nA : cA + (size_t)(t + 2) * kstep; const char* b2 = last ? nB : cB + (size_t)(t + 2) * kstep;
            const char* a3 = a2 + kstep; const char* b3 = b2 + kstep;
            if (last && has_next) S.a_ready(nxt);
            if constexpr (SP2) {
            PG8_LDB(B0, 0, 0); PG8_LDB(B1, 0, 1); PG8_SCHED; PG8_LDA(At, 0, 0); PG8_STAGE(PG8_SA(1, 1), a1 + hsAc, voffA);
            PG8_WAIT_V(8); PG8_WAIT_L(0); PG8_BAR; PG8_MMA(0, 0, At, B0); PG8_MMA(0, 1, At, B1); PG8_BAR; PG8_SCHED;
            PG8_LDA(At, 0, 1); PG8_STAGE(PG8_SB(0, 0), b2, voffB); PG8_STAGE(PG8_SB(0, 1), b2 + hstep, voffB); PG8_STAGE(PG8_SA(0, 0), a2, voffA);
            PG8_WAIT_V(8); PG8_WAIT_L(0); PG8_BAR; if (full) { PG8_MMA(1, 0, At, B0); PG8_MMA(1, 1, At, B1); } PG8_BAR; PG8_SCHED;
            PG8_LDB(B0, 1, 0); PG8_LDB(B1, 1, 1); PG8_SCHED; PG8_LDA(At, 1, 0); PG8_STAGE(PG8_SA(0, 1), a2 + (last ? hsAn : hsAc), voffA);
            PG8_WAIT_V(8); PG8_WAIT_L(0); PG8_BAR; PG8_MMA(0, 0, At, B0); PG8_MMA(0, 1, At, B1); PG8_BAR; PG8_SCHED;
            PG8_LDA(At, 1, 1); PG8_STAGE(PG8_SB(1, 0), b3, voffB); PG8_STAGE(PG8_SB(1, 1), b3 + hstep, voffB); PG8_STAGE(PG8_SA(1, 0), a3, voffA);
            PG8_WAIT_V(8); PG8_WAIT_L(0); PG8_BAR; if (full) { PG8_MMA(1, 0, At, B0); PG8_MMA(1, 1, At, B1); } PG8_BAR; PG8_SCHED;
            } else {
            PG8_LDB(B0, 0, 0); PG8_SCHED; PG8_LDA(At, 0, 0); PG8_STAGE(PG8_SA(1, 1), a1 + hstep, voffA);
            PG8_WAIT_L(8); PG8_BAR; PG8_WAIT_L(0); PG8_MMA(0, 0, At, B0); PG8_BAR; PG8_SCHED;
            PG8_LDB(B1, 0, 1); PG8_STAGE(PG8_SB(0, 0), b2, voffB);
            PG8_BAR; PG8_WAIT_L(0); PG8_MMA(0, 1, At, B1); PG8_BAR;
            PG8_LDA(At, 0, 1); PG8_STAGE(PG8_SA(0, 0), a2, voffA);
            PG8_BAR; PG8_WAIT_L(0); PG8_MMA(1, 0, At, B0); PG8_BAR; PG8_SCHED;
            PG8_STAGE(PG8_SB(0, 1), b2 + hstep, voffB);
            PG8_WAIT_V(6); PG8_BAR; PG8_MMA(1, 1, At, B1); PG8_BAR;
            PG8_LDB(B0, 1, 0); PG8_SCHED; PG8_LDA(At, 1, 0); PG8_STAGE(PG8_SA(0, 1), a2 + hstep, voffA);
            PG8_WAIT_L(8); PG8_BAR; PG8_WAIT_L(0); PG8_MMA(0, 0, At, B0); PG8_BAR; PG8_SCHED;
            PG8_LDB(B1, 1, 1); PG8_STAGE(PG8_SB(1, 0), b3, voffB);
            PG8_BAR; PG8_WAIT_L(0); PG8_MMA(0, 1, At, B1); PG8_BAR;
            PG8_LDA(At, 1, 1); PG8_STAGE(PG8_SA(1, 0), a3, voffA);
            PG8_BAR; PG8_WAIT_L(0); PG8_MMA(1, 0, At, B0); PG8_BAR; PG8_SCHED;
            PG8_STAGE(PG8_SB(1, 1), b3 + hstep, voffB);
            PG8_WAIT_V(6); PG8_BAR; PG8_MMA(1, 1, At, B1); PG8_BAR;
            }
        }
        if constexpr (ALIGN_EPI) { if (wr == 0) PG8_BAR; }
        if constexpr (!Epi::AFTER_DRAIN) { E(acc, cur, wr, wc, fr, fq); S.done(cur); }
        if (!has_next) break;
#pragma unroll
        for (int a = 0; a < 2; ++a)
#pragma unroll
            for (int b = 0; b < 2; ++b)
#pragma unroll
                for (int m = 0; m < 4; ++m)
#pragma unroll
                    for (int n = 0; n < 2; ++n) acc[a][b][m][n] = (f32x4){0.f, 0.f, 0.f, 0.f};
        cur = nxt; cA = nA; cB = nB; hsAc = hsAn; ++ui;
        if constexpr (ALIGN_EPI) { if (wr == 1) PG8_BAR; }
    }
    PG8_WAIT_V(0);
    if constexpr (!ALIGN_EPI) { if (wr == 0) PG8_BAR; }
    PG8_BAR;
    if constexpr (Epi::AFTER_DRAIN) { E.fused(acc, cur, wr, wc, fr, fq, lds, wid, lane); S.done(cur); }
#undef PG8_SA
#undef PG8_SB
#undef PG8_STAGE
#undef PG8_LDA
#undef PG8_LDB
#undef PG8_MMA
#undef PG8_WAIT_V
#undef PG8_WAIT_L
#undef PG8_BAR
#undef PG8_SCHED
}
}

constexpr int NWAVES = 8;
constexpr int BATCH = 2, SEQ = 8192, D = 1024, M = BATCH * SEQ;
constexpr int INC = 3592, NIN = 3584, FF = 2816, NGU = 2 * FF, NMOD = 6 * D;
constexpr int C_QA = 0, C_KA = 512, C_VA = 1024, C_QM = 1536, C_KM = 2048, C_VM = 2560, C_OG = 3072;
constexpr float RMS_EPS = 1e-6f;
constexpr size_t MiB = 1u << 20;
constexpr size_t WS_CTL = 0, CTL_ZERO_BYTES = 32 * 1024;
constexpr size_t WS_MOD = 1 * MiB;
constexpr size_t WS_GATES = 1 * MiB + 512 * 1024;
constexpr size_t WS_WIN = 2 * MiB, WS_WOUT = 9 * MiB, WS_WGU = 11 * MiB, WS_WDN = 22 * MiB;
constexpr size_t WS_STC = 28 * MiB, WS_STN = 44 * MiB, WS_STS = 44 * MiB + 512 * 1024;
constexpr size_t WS_XN = 48 * MiB;
constexpr size_t WS_CAT = 80 * MiB;
constexpr size_t WS_XIN = 112 * MiB;
constexpr size_t WS_H = 112 * MiB;
constexpr size_t WS_X1B = 200 * MiB;
constexpr size_t WS_AUX = 232 * MiB;
constexpr size_t WS_END = 256 * MiB;
static_assert(WS_WDN + (size_t)D * FF * 2 <= WS_STC && WS_XIN + (size_t)M * NIN * 2 <= 224 * MiB && WS_H + (size_t)M * FF * 2 <= WS_X1B && WS_X1B + (size_t)M * D * 2 <= WS_AUX, "ws map");
constexpr int CW_TMO = 0, CW_CODE = 1, CW_READY = 32, CW_MODCNT = 64, CW_BAR = 4096;
constexpr unsigned CW_MAGIC = 0x600DF00Du;
constexpr int RING_OFF = 0, RING_BYTES = 131072;
constexpr int LDSCTL_OFF = 147456, MISC_OFF = LDSCTL_OFF + 320;
constexpr int LDS_BYTES = LDSCTL_OFF + 4096;
#define GAS __attribute__((address_space(1)))
#define LAS __attribute__((address_space(3)))
typedef unsigned short bf16;
typedef unsigned v4u __attribute__((ext_vector_type(4)));
typedef unsigned v2u __attribute__((ext_vector_type(2)));
typedef float f32x4 __attribute__((ext_vector_type(4)));
typedef short bf16x8 __attribute__((ext_vector_type(8)));
typedef GAS unsigned gu32;
#define RLX_AGENT __ATOMIC_RELAXED, __HIP_MEMORY_SCOPE_AGENT
#define LDS_WAIT() asm volatile("s_waitcnt lgkmcnt(0)" ::: "memory")
#define VM_WAIT() asm volatile("s_waitcnt vmcnt(0)" ::: "memory")
#define WG_BAR() do { asm volatile("s_waitcnt lgkmcnt(0)" ::: "memory"); __builtin_amdgcn_s_barrier(); asm volatile("" ::: "memory"); } while (0)
typedef __bf16 bf16n2 __attribute__((ext_vector_type(2)));
__device__ __forceinline__ unsigned f2bf(float f) { return (unsigned)__builtin_bit_cast(unsigned short, (__bf16)f); }
__device__ __forceinline__ unsigned pk2(float lo, float hi) { const bf16n2 v = {(__bf16)lo, (__bf16)hi}; return __builtin_bit_cast(unsigned, v); }
typedef short s16x4 __attribute__((ext_vector_type(4)));
__device__ __forceinline__ v2u lds_tr16(const LAS unsigned char* p) { return __builtin_bit_cast(v2u, __builtin_amdgcn_ds_read_tr16_b64_v4i16((LAS s16x4*)p)); }
__device__ __forceinline__ void st16_wt(void* base, unsigned nbytes, size_t byte_off, v4u v) {
    const __amdgpu_buffer_rsrc_t rs = __builtin_amdgcn_make_buffer_rsrc(base, 0, (int)nbytes, 0x00020000);
    __builtin_amdgcn_raw_buffer_store_b128(v, rs, (unsigned)byte_off, 0, 16);
}
__device__ __forceinline__ float bf2f(unsigned short u) { return __builtin_bit_cast(float, (unsigned)u << 16); }
__device__ __forceinline__ float bflo(unsigned w) { return __builtin_bit_cast(float, w << 16); }
__device__ __forceinline__ float bfhi(unsigned w) { return __builtin_bit_cast(float, w & 0xffff0000u); }
typedef unsigned u32x2_t __attribute__((ext_vector_type(2)));
template <int CTRL> __device__ __forceinline__ float dppf(float v) { return __builtin_bit_cast(float, __builtin_amdgcn_update_dpp(0, __builtin_bit_cast(int, v), CTRL, 0xF, 0xF, true)); }
template <int CTRL> __device__ __forceinline__ float dppf_old(float old, float v) { return __builtin_bit_cast(float, __builtin_amdgcn_update_dpp(__builtin_bit_cast(int, old), __builtin_bit_cast(int, v), CTRL, 0xF, 0xF, false)); }
constexpr int DPP_X1 = 0xB1, DPP_X2 = 0x4E, DPP_HMIR = 0x141, DPP_MIR = 0x140, DPP_ROR8 = 0x128;
__device__ __forceinline__ float sum_x16(float v) { const unsigned b = __builtin_bit_cast(unsigned, v); const u32x2_t r = __builtin_amdgcn_permlane16_swap(b, b, false, false); const unsigned a0 = r[0], a1 = r[1]; return __builtin_bit_cast(float, a0) + __builtin_bit_cast(float, a1); }
__device__ __forceinline__ float sum_x32(float v) { const unsigned b = __builtin_bit_cast(unsigned, v); const u32x2_t r = __builtin_amdgcn_permlane32_swap(b, b, false, false); const unsigned a0 = r[0], a1 = r[1]; return __builtin_bit_cast(float, a0) + __builtin_bit_cast(float, a1); }
__device__ __forceinline__ float max_x16(float v) { const unsigned b = __builtin_bit_cast(unsigned, v); const u32x2_t r = __builtin_amdgcn_permlane16_swap(b, b, false, false); const unsigned a0 = r[0], a1 = r[1]; return fmaxf(__builtin_bit_cast(float, a0), __builtin_bit_cast(float, a1)); }
__device__ __forceinline__ float max_x32(float v) { const unsigned b = __builtin_bit_cast(unsigned, v); const u32x2_t r = __builtin_amdgcn_permlane32_swap(b, b, false, false); const unsigned a0 = r[0], a1 = r[1]; return fmaxf(__builtin_bit_cast(float, a0), __builtin_bit_cast(float, a1)); }
__device__ __forceinline__ float shfl_x16(float v, int lane) { const unsigned b = __builtin_bit_cast(unsigned, v); const u32x2_t r = __builtin_amdgcn_permlane16_swap(b, b, false, false); const unsigned a0 = r[0], a1 = r[1]; return __builtin_bit_cast(float, (lane & 16) ? a0 : a1); }
__device__ __forceinline__ float shfl_x32(float v, int lane) { const unsigned b = __builtin_bit_cast(unsigned, v); const u32x2_t r = __builtin_amdgcn_permlane32_swap(b, b, false, false); const unsigned a0 = r[0], a1 = r[1]; return __builtin_bit_cast(float, (lane & 32) ? a0 : a1); }
__device__ __forceinline__ float grp8_sum(float v) { v += dppf<DPP_X1>(v); v += dppf<DPP_X2>(v); v += dppf<DPP_HMIR>(v); return v; }
__device__ __forceinline__ float grp16_sum(float v) { v = grp8_sum(v); v += dppf<DPP_MIR>(v); return v; }
__device__ __forceinline__ float wave_sum(float v) { v = grp16_sum(v); v = sum_x16(v); return sum_x32(v); }
__device__ __forceinline__ float lane_bcast(float v, int l) { return __builtin_bit_cast(float, __builtin_amdgcn_readlane(__builtin_bit_cast(int, v), l)); }
__device__ __forceinline__ float wave_scan_sum(float v, int lane) {
    v += dppf<0x111>(v); v += dppf<0x112>(v); v += dppf<0x114>(v); v += dppf<0x118>(v);
    const float s0 = lane_bcast(v, 15), s1 = lane_bcast(v, 31), s2 = lane_bcast(v, 47); const int row = lane >> 4;
    return v + (row == 0 ? 0.f : row == 1 ? s0 : row == 2 ? s0 + s1 : (s0 + s1) + s2);
}
__device__ __forceinline__ float wave_scan_max(float v, int lane) {
    const float ninf = -INFINITY;
    v = fmaxf(v, dppf_old<0x111>(ninf, v)); v = fmaxf(v, dppf_old<0x112>(ninf, v)); v = fmaxf(v, dppf_old<0x114>(ninf, v)); v = fmaxf(v, dppf_old<0x118>(ninf, v));
    const float s0 = lane_bcast(v, 15), s1 = lane_bcast(v, 31), s2 = lane_bcast(v, 47); const int row = lane >> 4;
    return fmaxf(v, row == 0 ? ninf : row == 1 ? s0 : row == 2 ? fmaxf(s0, s1) : fmaxf(fmaxf(s0, s1), s2));
}
__device__ __forceinline__ float silu(float x) { return x / (1.0f + __expf(-x)); }
__device__ __forceinline__ float sigmoidf_(float x) { return 1.0f / (1.0f + __expf(-x)); }
__device__ __forceinline__ float log_sigmoid(float z) { return fminf(z, 0.f) - log1pf(__expf(-fabsf(z))); }

#define XB_TMO      128
#define XB_XCNT(j)  (256  + 64 * (j))
#define XB_XSUB(j)  (1280 + 64 * (j))
#define XB_XGEN(j)  (2304 + 64 * (j))
#define XB_TOP      3328
#define XB_TOPGEN   3392
#define XCD_BAR_WORDS 3456
#define XB_SPIN_CAP (1u << 18)

__device__ __forceinline__ unsigned xb_ld(unsigned* p)              { return __hip_atomic_load(p, __ATOMIC_RELAXED, __HIP_MEMORY_SCOPE_AGENT); }
__device__ __forceinline__ unsigned xb_add(unsigned* p, unsigned v) { return __hip_atomic_fetch_add(p, v, __ATOMIC_RELAXED, __HIP_MEMORY_SCOPE_AGENT); }
__device__ __forceinline__ unsigned xb_xcc_id() { return (unsigned)__builtin_amdgcn_s_getreg((3 << 11) | 20) & 0xFu; }
#define XB_SPIN(cond, bar) do { unsigned _sp = 0; while (cond) { __builtin_amdgcn_s_sleep(1); \
    if ((++_sp & 255u) == 0u) { if (xb_ld(&(bar)[XB_TMO])) break; if (_sp > XB_SPIN_CAP) { atomicAdd(&(bar)[XB_TMO], 1u); break; } } } } while (0)

struct XcdBarrier {
    unsigned* bar; unsigned x;
    volatile LAS unsigned* st;
};

__device__ __forceinline__ XcdBarrier xcd_barrier_post(unsigned* bar, volatile LAS unsigned* st) {
    XcdBarrier b; b.bar = bar; b.x = xb_xcc_id(); b.st = st;
    if (threadIdx.x == 0) (void)xb_add(&bar[XB_XCNT(b.x)], 1u);
    return b;
}
__device__ __forceinline__ void xcd_barrier_complete(unsigned* bar, unsigned x, unsigned& nloc, unsigned& nx) {
    const unsigned G = gridDim.x * gridDim.y * gridDim.z;
    unsigned sum, cnt, mine, sp = 0u;
    for (;;) {
        sum = 0u; cnt = 0u; mine = 0u;
#pragma unroll
        for (unsigned j = 0; j < 16; ++j) { const unsigned c = xb_ld(&bar[XB_XCNT(j)]); sum += c; cnt += (c > 0u) ? 1u : 0u; mine = (j == x) ? c : mine; }
        if (sum == G) break;
        __builtin_amdgcn_s_sleep(1);
        if ((++sp & 255u) == 0u) { if (xb_ld(&bar[XB_TMO])) break; if (sp > XB_SPIN_CAP) { atomicAdd(&bar[XB_TMO], 1u); break; } }
    }
    nloc = mine > 0u ? mine : 1u; nx = cnt > 0u ? cnt : 1u;
}

template <int MODE = 0>
__device__ __forceinline__ void xcd_barrier(const XcdBarrier& b) {
    asm volatile("s_waitcnt vmcnt(0)" ::: "memory");
    __syncthreads();
    if (threadIdx.x < 64) {
        unsigned* bar = b.bar; const int lane = (int)threadIdx.x;
        unsigned gen = 0u;
        if (lane == 0) {
            __builtin_amdgcn_s_waitcnt(0);
            unsigned nloc = b.st[0], nx = b.st[1];
            if (nloc == 0u) { xcd_barrier_complete(bar, b.x, nloc, nx); unsigned mask = 0u;
#pragma unroll
                for (unsigned j = 0; j < 16; ++j) mask |= (xb_ld(&bar[XB_XCNT(j)]) > 0u ? 1u : 0u) << j;
                b.st[0] = nloc; b.st[1] = nx; b.st[2] = mask; }
            const unsigned old = xb_add(&bar[XB_XSUB(b.x)], 1u);
            gen = old / nloc;
            if (old + 1u == (gen + 1u) * nloc) {
                if (!(MODE & 1)) __builtin_amdgcn_fence(__ATOMIC_RELEASE, "agent");
                asm volatile("s_waitcnt vmcnt(0)" ::: "memory");
                xb_add(&bar[XB_XGEN(b.x)], 1u);
            }
        }
        gen = (unsigned)__builtin_amdgcn_readfirstlane((int)gen);
        const bool watch = lane < 16 && ((b.st[2] >> (lane & 15)) & 1u) != 0u;
        unsigned sp = 0u;
        for (;;) {
            const bool ok = !watch || xb_ld(&bar[XB_XGEN(lane & 15)]) > gen;
            if (__all(ok)) break;
            __builtin_amdgcn_s_sleep(4);
            if ((++sp & 255u) == 0u) { if (__builtin_amdgcn_readfirstlane((int)xb_ld(&bar[XB_TMO])) != 0) break; if (sp > XB_SPIN_CAP) { if (lane == 0) atomicAdd(&bar[XB_TMO], 1u); break; } }
        }
        if (!(MODE & 2)) __builtin_amdgcn_fence(__ATOMIC_ACQUIRE, "agent");
        asm volatile("s_waitcnt vmcnt(0)" ::: "memory");
    }
    __syncthreads();
}
struct Frame {
    LAS unsigned char* lds; volatile LAS unsigned* MISC; gu32* ctl;
    int tid, lane, wave, vcu, G;
    const float *x, *c, *g_mix, *w_in, *w_conv, *b_conv, *b_ig, *b_fg, *qn_g, *kn_g, *mn_g, *w_out, *g_ffn, *w_gate, *w_up, *w_down, *w_ada, *b_ada;
    float* out; unsigned char* ws;
};

template <int MODE>
__device__ __forceinline__ void p0_transpose_item(const float* W, int K, int ldw, int nblk, bf16* WT, unsigned wt_bytes, LAS float* scr, int item, int lane) {
    const int kb = item / nblk, nb = item % nblk, k0 = 64 * kb, n0 = 32 * nb;
    float tv[32];
#pragma unroll
    for (int i = 0; i < 32; ++i) tv[i] = __builtin_nontemporal_load(W + (size_t)(k0 + 2 * i + (lane >> 5)) * ldw + n0 + (lane & 31));
#pragma unroll
    for (int i = 0; i < 32; ++i) scr[(2 * i + (lane >> 5)) * 33 + (lane & 31)] = tv[i];
    LDS_WAIT(); asm volatile("" ::: "memory");
    const int c = lane & 7;
#pragma unroll
    for (int j = 0; j < 4; ++j) { const int n = (lane >> 3) + 8 * j; const LAS float* s = scr + (8 * c) * 33 + n;
        v4u o; o.x = pk2(s[0 * 33], s[1 * 33]); o.y = pk2(s[2 * 33], s[3 * 33]); o.z = pk2(s[4 * 33], s[5 * 33]); o.w = pk2(s[6 * 33], s[7 * 33]);
        int row = n0 + n; if (MODE) row = ((row >> 7) << 8) + (row & 127) + (MODE == 2 ? 128 : 0);
        st16_wt(WT, wt_bytes, ((size_t)row * K + k0 + 8 * c) * 2, o); }
    LDS_WAIT(); asm volatile("" ::: "memory");
}
__device__ __forceinline__ void p0_prologue(Frame& F) {
    {
        LAS float* red = (LAS float*)(F.lds + RING_OFF);
        float* mod = (float*)(F.ws + WS_MOD);
        for (int cg = blockIdx.x; cg < 256; cg += F.G) {
            const int n0 = 24 * cg;
            float acc[2][24];
#pragma unroll
            for (int i = 0; i < 24; ++i) { acc[0][i] = 0.f; acc[1][i] = 0.f; }
            for (int k = F.tid; k < D; k += NWAVES * 64) {
                const float s0 = silu(F.c[k]), s1 = silu(F.c[D + k]);
                const f32x4* wr = (const f32x4*)(F.w_ada + (size_t)k * NMOD + n0);
#pragma unroll
                for (int i = 0; i < 6; ++i) { const f32x4 w = __builtin_nontemporal_load(wr + i);
#pragma unroll
                    for (int e = 0; e < 4; ++e) { acc[0][4 * i + e] += s0 * w[e]; acc[1][4 * i + e] += s1 * w[e]; } }
            }
#pragma unroll
            for (int i = 0; i < 24; ++i) { acc[0][i] = wave_sum(acc[0][i]); acc[1][i] = wave_sum(acc[1][i]); }
            if (F.lane == 0) {
#pragma unroll
                for (int i = 0; i < 24; ++i) { red[F.wave * 48 + i] = acc[0][i]; red[F.wave * 48 + 24 + i] = acc[1][i]; } }
            __syncthreads();
            if (F.tid < 48) { float s = 0.f;
#pragma unroll
                for (int w = 0; w < NWAVES; ++w) s += red[w * 48 + F.tid];
                const int b = F.tid / 24, n = n0 + F.tid % 24; mod[b * NMOD + n] = s + F.b_ada[n]; }
            __syncthreads();
        }
    }
}
__device__ __forceinline__ void p0_win_copy(Frame& F) {
    LAS float* scr = (LAS float*)(F.lds + RING_OFF + F.wave * 16384);
    const int gw = F.vcu * NWAVES + F.wave, NGW = F.G * NWAVES;
    constexpr int I_IN = (D / 64) * (NIN / 32);
    bf16* Win_t = (bf16*)(F.ws + WS_WIN);
    for (int it = gw; it < I_IN; it += NGW) p0_transpose_item<0>(F.w_in, D, INC, NIN / 32, Win_t, (unsigned)(NIN * D * 2), scr, it, F.lane);
}
__device__ __forceinline__ void p0_late_weights(Frame& F, int first) {
    LAS float* scr = (LAS float*)(F.lds + RING_OFF + F.wave * 16384);
    const int nwg = F.G - first; if ((int)blockIdx.x < first || nwg <= 0) return;
    const int gw = ((int)blockIdx.x - first) * NWAVES + F.wave, NGW = nwg * NWAVES;
    constexpr int I_OUT = (D / 64) * (D / 32), I_G = (D / 64) * (FF / 32), I_DN = (FF / 64) * (D / 32);
    constexpr int NITEMS = I_OUT + 2 * I_G + I_DN;
    bf16* Wout_t = (bf16*)(F.ws + WS_WOUT); bf16* Wgu_t = (bf16*)(F.ws + WS_WGU); bf16* Wdn_t = (bf16*)(F.ws + WS_WDN);
    for (int it = gw; it < NITEMS; it += NGW) {
        int r = it;
        if (r < I_OUT) { p0_transpose_item<0>(F.w_out, D, D, D / 32, Wout_t, (unsigned)(D * D * 2), scr, r, F.lane); continue; } r -= I_OUT;
        if (r < I_G) { p0_transpose_item<1>(F.w_gate, D, FF, FF / 32, Wgu_t, (unsigned)(NGU * D * 2), scr, r, F.lane); continue; } r -= I_G;
        if (r < I_G) { p0_transpose_item<2>(F.w_up, D, FF, FF / 32, Wgu_t, (unsigned)(NGU * D * 2), scr, r, F.lane); continue; } r -= I_G;
        p0_transpose_item<0>(F.w_down, FF, D, D / 32, Wdn_t, (unsigned)(D * FF * 2), scr, r, F.lane);
    }
}
template <bool GATES, bool SRCB16 = false>
__device__ __forceinline__ void norm_rows(Frame& F, const float* src, const float* g, const float* mshift, const float* mscale, bf16* XN, float* gates) {
    LAS float* gwl = (LAS float*)(F.lds + RING_OFF);
    if (GATES) {
        for (int i = F.tid; i < 8 * D; i += NWAVES * 64) { const int k = i >> 3, j = i & 7; gwl[j * D + k] = F.w_in[(size_t)k * INC + NIN + j]; }
        __syncthreads();
    }
    const int gw = F.vcu * NWAVES + F.wave, NGW = F.G * NWAVES;
    f32x4 gs[4], sh[4]; int bcur = -1;
    for (int m = gw; m < M; m += 2 * NGW) {
        const int m2 = m + NGW; const bool has2 = m2 < M;
        f32x4 v[4], v2[4];
        if (SRCB16) {
            const GAS v2u* xr = (const GAS v2u*)((const bf16*)src + (size_t)m * D) + F.lane; const GAS v2u* xr2 = (const GAS v2u*)((const bf16*)src + (size_t)(has2 ? m2 : m) * D) + F.lane;
#pragma unroll
            for (int j = 0; j < 4; ++j) { const v2u a = xr[64 * j], b2 = xr2[64 * j]; v[j] = (f32x4){bflo(a.x), bfhi(a.x), bflo(a.y), bfhi(a.y)}; v2[j] = (f32x4){bflo(b2.x), bfhi(b2.x), bflo(b2.y), bfhi(b2.y)}; }
        } else {
            const GAS f32x4* xr = (const GAS f32x4*)(src + (size_t)m * D) + F.lane; const GAS f32x4* xr2 = (const GAS f32x4*)(src + (size_t)(has2 ? m2 : m) * D) + F.lane;
#pragma unroll
            for (int j = 0; j < 4; ++j) { v[j] = __builtin_nontemporal_load(xr + 64 * j); v2[j] = __builtin_nontemporal_load(xr2 + 64 * j); }
        }
#pragma unroll 1
        for (int half = 0; half < 2; ++half) {
            if (half == 1 && !has2) break;
            const int mm = half ? m2 : m; const int b = mm / SEQ;
            if (b != bcur) { bcur = b;
#pragma unroll
                for (int j = 0; j < 4; ++j) { const int k0 = 256 * j + 4 * F.lane; gs[j] = *(const f32x4*)(g + k0) * (*(const f32x4*)(mscale + (size_t)b * NMOD + k0) + 1.0f); sh[j] = *(const f32x4*)(mshift + (size_t)b * NMOD + k0); } }
            float ss = 0.f;
#pragma unroll
            for (int j = 0; j < 4; ++j) { if (half) v[j] = v2[j]; ss += (v[j].x * v[j].x + v[j].y * v[j].y) + (v[j].z * v[j].z + v[j].w * v[j].w); }
            const float rstd = 1.0f / sqrtf(wave_sum(ss) * (1.f / D) + RMS_EPS);
            float ga[8];
#pragma unroll
            for (int c = 0; c < 8; ++c) ga[c] = 0.f;
            GAS unsigned long long* o8 = (GAS unsigned long long*)(XN + (size_t)mm * D) + F.lane;
#pragma unroll
            for (int j = 0; j < 4; ++j) {
                const int k0 = 256 * j + 4 * F.lane;
                const f32x4 h = (v[j] * rstd) * gs[j] + sh[j];
                o8[64 * j] = (unsigned long long)pk2(h.x, h.y) | ((unsigned long long)pk2(h.z, h.w) << 32);
                if (GATES) {
#pragma unroll
                    for (int c = 0; c < 8; ++c) { const f32x4 w4 = *(const LAS f32x4*)(gwl + c * D + k0); ga[c] += (h.x * w4.x + h.y * w4.y) + (h.z * w4.z + h.w * w4.w); }
                }
            }
            if (GATES) {
                const bool up = F.lane & 32, b4 = F.lane & 16, b3 = F.lane & 8;
                float k4[4], k2[2];
#pragma unroll
                for (int i = 0; i < 4; ++i) { const float snd = up ? ga[i] : ga[4 + i]; k4[i] = (up ? ga[4 + i] : ga[i]) + shfl_x32(snd, F.lane); }
#pragma unroll
                for (int i = 0; i < 2; ++i) { const float snd = b4 ? k4[i] : k4[2 + i]; k2[i] = (b4 ? k4[2 + i] : k4[i]) + shfl_x16(snd, F.lane); }
                float gv = (b3 ? k2[1] : k2[0]) + dppf<DPP_ROR8>(b3 ? k2[0] : k2[1]);
                gv = grp8_sum(gv);
                if ((F.lane & 7) == 0) { const int c = 4 * (F.lane >> 5) + 2 * ((F.lane >> 4) & 1) + ((F.lane >> 3) & 1);
                    gates[(size_t)mm * 8 + c] = c < 4 ? gv + F.b_ig[c] : log_sigmoid(gv + F.b_fg[c - 4]); }
            }
        }
    }
}
namespace pg8 {
struct EpiResToB16 {
    static constexpr bool PERM = true, AFTER_DRAIN = false;
    const float* base; bf16_t* out; int ldc; const float* gate; int gate_stride; int rows_per_batch; size_t out_bytes;
    __device__ __forceinline__ void operator()(const f32x4 (&acc)[2][2][4][2], const Unit& u, int wr, int wc, int fr, int fq) const {
        const int col0 = u.pn * BM + wc * 32 + 8 * fq; const int b = (u.pm * BM) / rows_per_batch;
        f32x4 gv[2][2];
#pragma unroll
        for (int bj = 0; bj < 2; ++bj)
#pragma unroll
            for (int n = 0; n < 2; ++n) gv[bj][n] = *(const f32x4*)(gate + (size_t)b * gate_stride + col0 + bj * HALF + n * 4);
#pragma unroll
        for (int ai = 0; ai < 2; ++ai)
#pragma unroll
            for (int m = 0; m < 4; ++m) { const size_t off = (size_t)(u.pm * BM + ai * HALF + wr * 64 + m * 16 + fr) * ldc + col0;
#pragma unroll
                for (int bj = 0; bj < 2; ++bj) { const f32x4 b0 = __builtin_nontemporal_load((const f32x4*)(base + off + bj * HALF)), b1 = __builtin_nontemporal_load((const f32x4*)(base + off + bj * HALF + 4));
                    const f32x4 o0 = b0 + gv[bj][0] * acc[ai][bj][m][0], o1 = b1 + gv[bj][1] * acc[ai][bj][m][1];
                    u32x4 w; w.x = cvt_pk_bf16(o0[0], o0[1]); w.y = cvt_pk_bf16(o0[2], o0[3]); w.z = cvt_pk_bf16(o1[0], o1[1]); w.w = cvt_pk_bf16(o1[2], o1[3]);
                    st16_wt(out, (unsigned)out_bytes, (off + bj * HALF) * 2, __builtin_bit_cast(v4u, w)); } }
    }
};
struct EpiResFromB16 {
    static constexpr bool PERM = true, AFTER_DRAIN = false;
    const bf16_t* base; float* out; int ldc; const float* gate; int gate_stride; int rows_per_batch;
    __device__ __forceinline__ void operator()(const f32x4 (&acc)[2][2][4][2], const Unit& u, int wr, int wc, int fr, int fq) const {
        const int col0 = u.pn * BM + wc * 32 + 8 * fq; const int b = (u.pm * BM) / rows_per_batch;
        f32x4 gv[2][2];
#pragma unroll
        for (int bj = 0; bj < 2; ++bj)
#pragma unroll
            for (int n = 0; n < 2; ++n) gv[bj][n] = *(const f32x4*)(gate + (size_t)b * gate_stride + col0 + bj * HALF + n * 4);
#pragma unroll
        for (int ai = 0; ai < 2; ++ai)
#pragma unroll
            for (int m = 0; m < 4; ++m) { const size_t off = (size_t)(u.pm * BM + ai * HALF + wr * 64 + m * 16 + fr) * ldc + col0;
#pragma unroll
                for (int bj = 0; bj < 2; ++bj) { const u32x4 bw = __builtin_nontemporal_load((const u32x4*)(base + off + bj * HALF));
                    const f32x4 b0 = (f32x4){bflo(bw.x), bfhi(bw.x), bflo(bw.y), bfhi(bw.y)}, b1 = (f32x4){bflo(bw.z), bfhi(bw.z), bflo(bw.w), bfhi(bw.w)};
                    __builtin_nontemporal_store(b0 + gv[bj][0] * acc[ai][bj][m][0], (f32x4*)(out + off + bj * HALF)); __builtin_nontemporal_store(b1 + gv[bj][1] * acc[ai][bj][m][1], (f32x4*)(out + off + bj * HALF + 4)); } }
    }
};
}
constexpr int AT_KROWS = 256, AT_KSTR = 144  , AT_VSTR = 144  ;
constexpr int AT_VT_OFF = AT_KROWS * AT_KSTR, AT_BUF = AT_VT_OFF + AT_KROWS * AT_VSTR;
constexpr int AT_RK_OFF = LDSCTL_OFF + 1024;
static_assert(2 * AT_BUF <= LDSCTL_OFF && AT_RK_OFF + 2 * AT_KROWS * 4 <= LDS_BYTES, "attention LDS double buffer");
constexpr int AT_UNITS = 3 * 16 * 64;
struct AtUnit { int p, b, h, r, rho, i0; };
__device__ __forceinline__ AtUnit at_decode(int u) { AtUnit U; U.p = u >> 10; const int bh = (u >> 6) & 15, cb = u & 63; U.b = bh >> 3; U.h = bh & 7;
    const int sh = 2 * U.p; U.r = 1 << sh; const int nbc = 64 >> sh; U.rho = cb / nbc; U.i0 = 128 * (cb % nbc); return U; }
__device__ __forceinline__ void at_prefetch(const Frame& F, const bf16* XIN, int u, v4u (&pk)[4], v4u (&pv)[4], v4u (&pq)[2]) {
    const AtUnit U = at_decode(u); const int w = F.wave, fr = F.lane & 15, g = F.lane >> 4;
    const int kr0 = F.tid >> 3, c = F.tid & 7;
    const bf16* row0 = XIN + ((long)U.b * SEQ + (long)(U.i0 - 128 + kr0) * U.r + U.rho) * NIN + U.h * 64 + 8 * c;
    const long step = (long)64 * U.r * NIN;
#pragma unroll
    for (int it = 0; it < 4; ++it) { pk[it] = (v4u){0u, 0u, 0u, 0u}; pv[it] = (v4u){0u, 0u, 0u, 0u};
        if (U.i0 - 128 + kr0 + 64 * it >= 0) { pk[it] = *(const v4u*)(row0 + it * step + C_KA); pv[it] = *(const v4u*)(row0 + it * step + C_VA); } }
    const bf16* qrow = XIN + ((size_t)U.b * SEQ + (size_t)(U.i0 + 16 * w + fr) * U.r + U.rho) * NIN + C_QA + U.h * 64 + 8 * g;
    pq[0] = *(const v4u*)qrow; pq[1] = *(const v4u*)(qrow + 32);
}
struct AtCarry { bf16x8 qf[2]; };
template <bool CMB>
__device__ __forceinline__ void at_stage(const Frame& F, const bf16* OP, const float* LSE, int u, int buf, const v4u (&pk)[4], const v4u (&pv)[4], const v4u (&pq)[2], const float (&gqk)[16], AtCarry& C) {
    LAS unsigned char* KL = F.lds + RING_OFF + buf * AT_BUF; LAS unsigned char* VL = KL + AT_VT_OFF; LAS float* RK = (LAS float*)(F.lds + AT_RK_OFF) + buf * AT_KROWS;
    const int lane = F.lane, w = F.wave, fr = lane & 15, g = lane >> 4;
    const AtUnit U = at_decode(u);
#pragma unroll
    for (int it = 0; it < 4; ++it) { const int kr = (F.tid >> 3) + 64 * it, c = F.tid & 7;
        const v4u kv = pk[it];
        float ss = 0.f;
#pragma unroll
        for (int e = 0; e < 4; ++e) { const unsigned ke = kv[e]; const bf16n2 k2 = __builtin_bit_cast(bf16n2, ke);     ss = __builtin_amdgcn_fdot2_f32_bf16(k2, k2, ss, false); }
        ss = grp8_sum(ss);
        *(LAS v4u*)(KL + kr * AT_KSTR + c * 16) = kv;
        *(LAS v4u*)(VL + kr * AT_VSTR + c * 16) = pv[it];
        if (c == 0) RK[kr] = __builtin_amdgcn_rsqf(ss * (1.f / 64) + RMS_EPS); }
    {
        float qv[16]; float ss = 0.f;
#pragma unroll
        for (int ks = 0; ks < 2; ++ks)
#pragma unroll
            for (int e = 0; e < 4; ++e) { qv[8 * ks + 2 * e] = bflo(pq[ks][e]); qv[8 * ks + 2 * e + 1] = bfhi(pq[ks][e]); }
#pragma unroll
        for (int i = 0; i < 16; ++i) ss += qv[i] * qv[i];
        ss = sum_x32(sum_x16(ss));
        const float rq = (0.125f * 1.44269504089f) * __builtin_amdgcn_rsqf(ss * (1.f / 64) + RMS_EPS);
#pragma unroll
        for (int ks = 0; ks < 2; ++ks) { v4u o;
#pragma unroll
            for (int e = 0; e < 4; ++e) o[e] = pk2(qv[8 * ks + 2 * e] * rq * gqk[8 * ks + 2 * e], qv[8 * ks + 2 * e + 1] * rq * gqk[8 * ks + 2 * e + 1]);
            C.qf[ks] = __builtin_bit_cast(bf16x8, o); }
    }
}
template <bool CMB>
__device__ __forceinline__ void at_compute(const Frame& F, bf16* OP, float* LSE, bf16* CAT, int u, int buf, const AtCarry& C) {
    const LAS unsigned char* KL = F.lds + RING_OFF + buf * AT_BUF; const LAS unsigned char* VL = KL + AT_VT_OFF; const LAS float* RK = (const LAS float*)(F.lds + AT_RK_OFF) + buf * AT_KROWS;
    const int lane = F.lane, w = F.wave, fr = lane & 15, g = lane >> 4;
    const AtUnit U = at_decode(u);
    const size_t mq = (size_t)U.b * SEQ + (size_t)(U.i0 + 16 * w + fr) * U.r + U.rho;
    v2u co[2][4]; float cl[2];
    if (CMB) {
#pragma unroll
        for (int q = 0; q < 2; ++q) { cl[q] = LSE[((size_t)(q + 1) * M + mq) * 8 + U.h];
#pragma unroll
            for (int dt = 0; dt < 4; ++dt) co[q][dt] = *(const v2u*)(OP + ((size_t)(q + 1) * M + mq) * 512 + U.h * 64 + 16 * dt + 4 * g); } }
    f32x4 sacc[9];
#pragma unroll
    for (int kt = 0; kt < 9; ++kt) { sacc[kt] = (f32x4){0.f, 0.f, 0.f, 0.f};
#pragma unroll
        for (int ks = 0; ks < 2; ++ks) { const bf16x8 a = *(const LAS bf16x8*)(KL + (16 * w + 16 * kt + fr) * AT_KSTR + (32 * ks + 8 * g) * 2);
            sacc[kt] = __builtin_amdgcn_mfma_f32_16x16x32_bf16(a, C.qf[ks], sacc[kt], 0, 0, 0); }
        sacc[kt] = sacc[kt] * *(const LAS f32x4*)(RK + 16 * w + 16 * kt + 4 * g); }
#pragma unroll
    for (int rr = 0; rr < 4; ++rr) { if (fr > 4 * g + rr) sacc[0][rr] = -INFINITY; if (fr < 4 * g + rr) sacc[8][rr] = -INFINITY; }
    if (U.i0 == 0) {
#pragma unroll
        for (int kt = 0; kt < 9; ++kt)
#pragma unroll
            for (int rr = 0; rr < 4; ++rr) if (16 * w + 16 * kt + 4 * g + rr < 128) sacc[kt][rr] = -INFINITY;
    }
    float mx = -INFINITY;
#pragma unroll
    for (int kt = 0; kt < 9; ++kt) mx = fmaxf(mx, fmaxf(fmaxf(sacc[kt][0], sacc[kt][1]), fmaxf(sacc[kt][2], sacc[kt][3])));
    mx = max_x32(max_x16(mx));
    float lsum = 0.f;
#pragma unroll
    for (int kt = 0; kt < 9; ++kt)
#pragma unroll
        for (int rr = 0; rr < 4; ++rr) { const float pv_ = __builtin_amdgcn_exp2f(sacc[kt][rr] - mx); sacc[kt][rr] = pv_; lsum += pv_; }
    lsum = sum_x32(sum_x16(lsum));
    f32x4 oacc[4];
#pragma unroll
    for (int dt = 0; dt < 4; ++dt) oacc[dt] = (f32x4){0.f, 0.f, 0.f, 0.f};
    const LAS unsigned char* vbase = VL + (16 * w + 4 * g + (fr >> 2)) * AT_VSTR + (fr & 3) * 8;
#pragma unroll
    for (int pp = 0; pp < 5; ++pp) {
        v4u pb; pb.x = pk2(sacc[2 * pp][0], sacc[2 * pp][1]); pb.y = pk2(sacc[2 * pp][2], sacc[2 * pp][3]);
        if (pp < 4) { pb.z = pk2(sacc[2 * pp + 1][0], sacc[2 * pp + 1][1]); pb.w = pk2(sacc[2 * pp + 1][2], sacc[2 * pp + 1][3]); } else { pb.z = 0u; pb.w = 0u; }
        const bf16x8 bfrag = __builtin_bit_cast(bf16x8, pb);
#pragma unroll
        for (int dt = 0; dt < 4; ++dt) { const LAS unsigned char* vr = vbase + (32 * pp) * AT_VSTR + 32 * dt;
            const v2u lo = lds_tr16(vr); v2u hi = (v2u){0u, 0u}; if (pp < 4) hi = lds_tr16(vr + 16 * AT_VSTR);
            const v4u av = (v4u){lo.x, lo.y, hi.x, hi.y};
            oacc[dt] = __builtin_amdgcn_mfma_f32_16x16x32_bf16(__builtin_bit_cast(bf16x8, av), bfrag, oacc[dt], 0, 0, 0); }
    }
    const float inv = __builtin_amdgcn_rcpf(lsum);
    const float lse0 = (mx + __log2f(lsum)) * 0.69314718056f;
    if (CMB) {
        const float mm = fmaxf(lse0, fmaxf(cl[0], cl[1])); float e0 = __expf(lse0 - mm), e1 = __expf(cl[0] - mm), e2 = __expf(cl[1] - mm);
        const float is = __builtin_amdgcn_rcpf(e0 + e1 + e2); e0 *= is * inv; e1 *= is; e2 *= is;
        bf16* crow = CAT + mq * 1024 + U.h * 64 + 4 * g;
#pragma unroll
        for (int dt = 0; dt < 4; ++dt) { v2u o;
            o.x = pk2(e0 * oacc[dt][0] + e1 * bflo(co[0][dt].x) + e2 * bflo(co[1][dt].x), e0 * oacc[dt][1] + e1 * bfhi(co[0][dt].x) + e2 * bfhi(co[1][dt].x));
            o.y = pk2(e0 * oacc[dt][2] + e1 * bflo(co[0][dt].y) + e2 * bflo(co[1][dt].y), e0 * oacc[dt][3] + e1 * bfhi(co[0][dt].y) + e2 * bfhi(co[1][dt].y));
            *(v2u*)(crow + 16 * dt) = o; }
    } else {
        bf16* orow = OP + ((size_t)U.p * M + mq) * 512 + U.h * 64 + 4 * g;
#pragma unroll
        for (int dt = 0; dt < 4; ++dt) { v2u o; o.x = pk2(oacc[dt][0] * inv, oacc[dt][1] * inv); o.y = pk2(oacc[dt][2] * inv, oacc[dt][3] * inv); *(v2u*)(orow + 16 * dt) = o; }
        if (g == 0) LSE[((size_t)U.p * M + mq) * 8 + U.h] = lse0;
    }
}
template <bool CMB>
__device__ __forceinline__ void attn_phase(Frame& F, const bf16* XIN, bf16* OP, float* LSE, bf16* CAT, int ubeg, int uend) {
    const int g = F.lane >> 4;
    float gqk[16];
#pragma unroll
    for (int ks = 0; ks < 2; ++ks)
#pragma unroll
        for (int i = 0; i < 8; ++i) { const int d = 32 * ks + 8 * g + i; gqk[8 * ks + i] = F.qn_g[d] * F.kn_g[d]; }
    const int per = (uend - ubeg + F.G - 1) / F.G; const int u0 = ubeg + F.vcu * per; const int u1 = (u0 + per < uend) ? u0 + per : uend; const int n = u1 - u0;
    if (n <= 0) return;
    v4u pkA[4], pvA[4], pqA[2], pkB[4], pvB[4], pqB[2]; AtCarry cur, nxt;
    at_prefetch(F, XIN, u0, pkA, pvA, pqA);
    if (n > 1) at_prefetch(F, XIN, u0 + 1, pkB, pvB, pqB);
    at_stage<CMB>(F, OP, LSE, u0, 0, pkA, pvA, pqA, gqk, cur);
    if (n > 2) at_prefetch(F, XIN, u0 + 2, pkA, pvA, pqA);
    WG_BAR();
    for (int i = 0; i < n; i += 2) {
        if (i + 1 < n) { at_stage<CMB>(F, OP, LSE, u0 + i + 1, 1, pkB, pvB, pqB, gqk, nxt); if (i + 3 < n) at_prefetch(F, XIN, u0 + i + 3, pkB, pvB, pqB); }
        at_compute<CMB>(F, OP, LSE, CAT, u0 + i, 0, cur);
        WG_BAR();
        if (i + 1 < n) {
            if (i + 2 < n) { at_stage<CMB>(F, OP, LSE, u0 + i + 2, 0, pkA, pvA, pqA, gqk, cur); if (i + 4 < n) at_prefetch(F, XIN, u0 + i + 4, pkA, pvA, pqA); }
            at_compute<CMB>(F, OP, LSE, CAT, u0 + i + 1, 1, nxt);
            WG_BAR();
        }
    }
}
constexpr int ML_G = 32, ML_NC = 4, ML_UNITS = 8 * ML_G;
static_assert(ML_G * ML_NC * 64 == SEQ, "mLSTM grouping");
constexpr int ML_RS = 288;
constexpr int ML_QN = 0, ML_KN = 18432, ML_KWN = 36864, ML_VN = 55296, ML_SD = 73728, ML_F = 82944, ML_CW = 87552, ML_RAWQ = 92672, ML_RAWK = 110896;
constexpr int ML_RAWS = 272;
static_assert(ML_RAWK + 67 * ML_RAWS <= RING_BYTES, "mLSTM LDS map");
constexpr int MF_U = 0, MF_M = 64, MF_B = 128, MF_RS = 192, MF_QN = 448, MF_NV = 512, MF_HSS = 640;
constexpr float K_SCALE = 0.08838834764831845f;
__device__ __forceinline__ void conv8_lds(const LAS unsigned char* raw, const LAS float* cw, int s, int c, float (&y)[8]) {
    const f32x4 b0 = *(const LAS f32x4*)(cw + 4 * 128 + 8 * c), b1 = *(const LAS f32x4*)(cw + 4 * 128 + 8 * c + 4);
    y[0] = b0[0]; y[1] = b0[1]; y[2] = b0[2]; y[3] = b0[3]; y[4] = b1[0]; y[5] = b1[1]; y[6] = b1[2]; y[7] = b1[3];
#pragma unroll
    for (int j = 0; j < 4; ++j) { const v4u x = *(const LAS v4u*)(raw + (s + j) * ML_RAWS + c * 16);
        const f32x4 w0 = *(const LAS f32x4*)(cw + j * 128 + 8 * c), w1 = *(const LAS f32x4*)(cw + j * 128 + 8 * c + 4);
        y[0] += w0[0] * bflo(x[0]); y[1] += w0[1] * bfhi(x[0]); y[2] += w0[2] * bflo(x[1]); y[3] += w0[3] * bfhi(x[1]);
        y[4] += w1[0] * bflo(x[2]); y[5] += w1[1] * bfhi(x[2]); y[6] += w1[2] * bflo(x[3]); y[7] += w1[3] * bfhi(x[3]); }
#pragma unroll
    for (int i = 0; i < 8; ++i) y[i] = y[i] * __builtin_amdgcn_rcpf(1.0f + __builtin_amdgcn_exp2f(-1.44269504089f * y[i]));
}
constexpr int M2_HT = 87552, M2_HTS = 528;
constexpr int MF_INT = 192, MF_EMT = 256;
static_assert(M2_HT + 64 * M2_HTS <= RING_BYTES, "pass-2 LDS map");
__device__ __forceinline__ void mlstm_pass2(Frame& F, const bf16* XIN, const bf16* QKc, const float* gates, bf16* CAT) {
    LAS unsigned char* L = F.lds + RING_OFF; LAS float* LF = (LAS float*)(L + ML_F);
    float* STC = (float*)(F.ws + WS_STC); float* STN = (float*)(F.ws + WS_STN); float* STS = (float*)(F.ws + WS_STS);
    const int lane0 = F.lane, w = F.wave, tid0 = F.tid;
#define ML_OPAQUE() int lane = lane0, tid = tid0; asm volatile("" : "+v"(lane), "+v"(tid)); const int fr = lane & 15, g = lane >> 4; (void)fr; (void)g; (void)tid
    v4u rq[2], rk[2], rv[2], ro[2]; float glf, gli;
#define M2_PREFETCH(unit_, ck_) do { const int bh_ = (unit_) / ML_G, grp_ = (unit_) % ML_G; const int b_ = bh_ >> 2, hh_ = bh_ & 3; const int t0_ = (grp_ * ML_NC + (ck_)) * 64; \
        ML_OPAQUE(); \
        _Pragma("unroll") for (int j = 0; j < 2; ++j) { const int item = tid + NWAVES * 64 * j; const size_t mr = (size_t)b_ * SEQ + t0_ + (item >> 4); const int c = item & 15; \
            rq[j] = *(const v4u*)(QKc + mr * 1024 + hh_ * 128 + 8 * c); rk[j] = *(const v4u*)(QKc + mr * 1024 + 512 + hh_ * 128 + 8 * c); \
            rv[j] = *(const v4u*)(XIN + mr * NIN + C_VM + hh_ * 128 + 8 * c); ro[j] = *(const v4u*)(XIN + mr * NIN + C_OG + hh_ * 128 + 8 * c); } \
        glf = gates[((size_t)b_ * SEQ + t0_ + lane) * 8 + 4 + hh_]; gli = gates[((size_t)b_ * SEQ + t0_ + lane) * 8 + hh_]; } while (0)
    if (F.vcu < ML_UNITS) M2_PREFETCH(F.vcu, 0);
    for (int unit = F.vcu; unit < ML_UNITS; unit += F.G) {
        const int bh = unit / ML_G, grp = unit % ML_G; const int b = bh >> 2, hh = bh & 3;
        f32x4 accC[8], accN; float mrun; f32x4 gn[2];
        { ML_OPAQUE();
#pragma unroll
          for (int dt = 0; dt < 8; ++dt) accC[dt] = *(const f32x4*)(STC + (size_t)unit * 16384 + ((w * 8 + dt) * 64 + lane) * 4);
          accN = *(const f32x4*)(STN + unit * 128 + 16 * w + 4 * g);
          mrun = STS[unit * 4 + 2]; if (fr == 0) *(LAS f32x4*)(LF + MF_NV + 16 * w + 4 * g) = accN;
          gn[0] = *(const f32x4*)(F.mn_g + hh * 128 + 8 * (tid & 15)); gn[1] = *(const f32x4*)(F.mn_g + hh * 128 + 8 * (tid & 15) + 4); }
#pragma unroll 1
        for (int ck = 0; ck < ML_NC; ++ck) {
            const int t0 = (grp * ML_NC + ck) * 64; const size_t m0 = (size_t)b * SEQ + t0;
            float blast, Mlast, decay; v4u og2[2];
            { ML_OPAQUE();
            const float lf = glf, li = gli;
            const float bc = wave_scan_sum(lf, lane);
            const float u = li - bc;
            const float pm = wave_scan_max(u, lane);
            const float Mt = fmaxf(mrun, pm);
            blast = lane_bcast(bc, 63); Mlast = lane_bcast(Mt, 63);
            const float wv = __expf(u - Mlast); decay = __expf(mrun - Mlast);
            if (w == 0) { LF[MF_U + lane] = u; LF[MF_M + lane] = Mt; LF[MF_INT + lane] = __expf(mrun - Mt); LF[MF_EMT + lane] = __expf(-(bc + Mt)); }
#pragma unroll
            for (int j = 0; j < 2; ++j) { const int item = tid + NWAVES * 64 * j; const int s = item >> 4, c = item & 15;
                const float wsc = __shfl(wv, s);
                *(LAS v4u*)(L + ML_QN + s * ML_RS + c * 16) = rq[j]; *(LAS v4u*)(L + ML_KN + s * ML_RS + c * 16) = rk[j]; *(LAS v4u*)(L + ML_VN + s * ML_RS + c * 16) = rv[j];
                v4u ow;
#pragma unroll
                for (int e = 0; e < 4; ++e) ow[e] = pk2(bflo(rk[j][e]) * wsc, bfhi(rk[j][e]) * wsc);
                *(LAS v4u*)(L + ML_KWN + s * ML_RS + c * 16) = ow; og2[j] = ro[j]; }
            }
            if (ck + 1 < ML_NC) M2_PREFETCH(unit, ck + 1); else if (unit + F.G < ML_UNITS) M2_PREFETCH(unit + F.G, 0);
            WG_BAR();
            bf16x8 vfrag[2];
            { ML_OPAQUE();
#pragma unroll
            for (int ks = 0; ks < 2; ++ks) { const LAS unsigned char* vp = L + ML_VN + (32 * ks + 8 * g + (fr >> 2)) * ML_RS + (16 * w + 4 * (fr & 3)) * 2;
                const v2u lo = lds_tr16(vp), hi = lds_tr16(vp + 4 * ML_RS); vfrag[ks] = __builtin_bit_cast(bf16x8, (v4u){lo.x, lo.y, hi.x, hi.y}); } }
            { ML_OPAQUE(); const int ti = w >> 1; const int t = 16 * ti + fr; const float Mt_t = LF[MF_M + t];
#pragma unroll
              for (int q = 0; q < 2; ++q) { const int si = 2 * (w & 1) + q; f32x4 acc = (f32x4){0.f, 0.f, 0.f, 0.f};
#pragma unroll
                for (int ks = 0; ks < 4; ++ks) { const bf16x8 a = *(const LAS bf16x8*)(L + ML_KN + (16 * si + fr) * ML_RS + (32 * ks + 8 * g) * 2);
                    const bf16x8 bq = *(const LAS bf16x8*)(L + ML_QN + (16 * ti + fr) * ML_RS + (32 * ks + 8 * g) * 2);
                    acc = __builtin_amdgcn_mfma_f32_16x16x32_bf16(a, bq, acc, 0, 0, 0); }
                const f32x4 us = *(const LAS f32x4*)(LF + MF_U + 16 * si + 4 * g); float sd[4];
#pragma unroll
                for (int rr = 0; rr < 4; ++rr) { const int s = 16 * si + 4 * g + rr; sd[rr] = (s <= t) ? acc[rr] * __expf(us[rr] - Mt_t) : 0.f; }
                v2u o; o.x = pk2(sd[0], sd[1]); o.y = pk2(sd[2], sd[3]);
                *(LAS v2u*)(L + ML_SD + t * 144 + (16 * si + 4 * g) * 2) = o; } }
            WG_BAR();
            { ML_OPAQUE();
            f32x4 hacc[4], qacc[4], racc[4];
#pragma unroll
            for (int ti = 0; ti < 4; ++ti) { hacc[ti] = (f32x4){0.f, 0.f, 0.f, 0.f}; qacc[ti] = (f32x4){0.f, 0.f, 0.f, 0.f}; racc[ti] = (f32x4){0.f, 0.f, 0.f, 0.f}; }
            bf16x8 qfr[4][4]; f32x4 nv0[4], nv1[4];
#pragma unroll
            for (int ks = 0; ks < 4; ++ks) { nv0[ks] = *(const LAS f32x4*)(LF + MF_NV + 32 * ks + 4 * g); nv1[ks] = *(const LAS f32x4*)(LF + MF_NV + 32 * ks + 16 + 4 * g);
#pragma unroll
                for (int ti = 0; ti < 4; ++ti) { const LAS unsigned char* qp = L + ML_QN + (16 * ti + fr) * ML_RS + (32 * ks + 4 * g) * 2;
                    const v2u lo = *(const LAS v2u*)qp, hi = *(const LAS v2u*)(qp + 32); qfr[ks][ti] = __builtin_bit_cast(bf16x8, (v4u){lo.x, lo.y, hi.x, hi.y}); } }
#pragma unroll
            for (int ks = 0; ks < 4; ++ks) {
                v4u cb; cb.x = pk2(accC[2 * ks][0], accC[2 * ks][1]); cb.y = pk2(accC[2 * ks][2], accC[2 * ks][3]); cb.z = pk2(accC[2 * ks + 1][0], accC[2 * ks + 1][1]); cb.w = pk2(accC[2 * ks + 1][2], accC[2 * ks + 1][3]);
                const bf16x8 cfrag = __builtin_bit_cast(bf16x8, cb);
                v4u nb; nb.x = pk2(nv0[ks][0], nv0[ks][1]); nb.y = pk2(nv0[ks][2], nv0[ks][3]); nb.z = pk2(nv1[ks][0], nv1[ks][1]); nb.w = pk2(nv1[ks][2], nv1[ks][3]);
                const bf16x8 nfrag = __builtin_bit_cast(bf16x8, nb);
#pragma unroll
                for (int ti = 0; ti < 4; ++ti) {
                    hacc[ti] = __builtin_amdgcn_mfma_f32_16x16x32_bf16(qfr[ks][ti], cfrag, hacc[ti], 0, 0, 0);
                    qacc[ti] = __builtin_amdgcn_mfma_f32_16x16x32_bf16(qfr[ks][ti], nfrag, qacc[ti], 0, 0, 0); }
            }
            f32x4 inter[4];
#pragma unroll
            for (int ti = 0; ti < 4; ++ti) { inter[ti] = *(const LAS f32x4*)(LF + MF_INT + 16 * ti + 4 * g); hacc[ti] = hacc[ti] * inter[ti]; }
            const bf16x8 ones = __builtin_bit_cast(bf16x8, (v4u){0x3f803f80u, 0x3f803f80u, 0x3f803f80u, 0x3f803f80u});
            bf16x8 sdf[2][4];
#pragma unroll
            for (int ks = 0; ks < 2; ++ks)
#pragma unroll
                for (int ti = 0; ti < 4; ++ti) sdf[ks][ti] = *(const LAS bf16x8*)(L + ML_SD + (16 * ti + fr) * 144 + (32 * ks + 8 * g) * 2);
#pragma unroll
            for (int ks = 0; ks < 2; ++ks)
#pragma unroll
                for (int ti = 0; ti < 4; ++ti) {
                    hacc[ti] = __builtin_amdgcn_mfma_f32_16x16x32_bf16(sdf[ks][ti], vfrag[ks], hacc[ti], 0, 0, 0);
                    racc[ti] = __builtin_amdgcn_mfma_f32_16x16x32_bf16(sdf[ks][ti], ones, racc[ti], 0, 0, 0); }
#pragma unroll
            for (int ti = 0; ti < 4; ++ti) { const f32x4 emt = *(const LAS f32x4*)(LF + MF_EMT + 16 * ti + 4 * g);
#pragma unroll
                for (int rr = 0; rr < 4; ++rr) { const float den = fmaxf(fabsf(inter[ti][rr] * qacc[ti][rr] + racc[ti][rr]), emt[rr]);
                    *(LAS float*)(L + M2_HT + (16 * ti + 4 * g + rr) * M2_HTS + (16 * w + fr) * 4) = hacc[ti][rr] * __builtin_amdgcn_rcpf(den); } }
            const LAS unsigned char* kp = L + ML_KWN + (8 * g + (fr >> 2)) * ML_RS + 4 * (fr & 3) * 2;
#pragma unroll
            for (int dt = 0; dt < 8; ++dt) accC[dt] = accC[dt] * decay;
            accN = accN * decay;
#pragma unroll
            for (int ks = 0; ks < 2; ++ks) {
                v2u klo[9], khi[9];
#pragma unroll
                for (int dt = 0; dt < 8; ++dt) { klo[dt] = lds_tr16(kp + 32 * ks * ML_RS + 32 * dt); khi[dt] = lds_tr16(kp + (32 * ks + 4) * ML_RS + 32 * dt); }
                klo[8] = lds_tr16(kp + 32 * ks * ML_RS + 32 * w); khi[8] = lds_tr16(kp + (32 * ks + 4) * ML_RS + 32 * w);
#pragma unroll
                for (int dt = 0; dt < 8; ++dt) accC[dt] = __builtin_amdgcn_mfma_f32_16x16x32_bf16(__builtin_bit_cast(bf16x8, (v4u){klo[dt].x, klo[dt].y, khi[dt].x, khi[dt].y}), vfrag[ks], accC[dt], 0, 0, 0);
                accN = __builtin_amdgcn_mfma_f32_16x16x32_bf16(__builtin_bit_cast(bf16x8, (v4u){klo[8].x, klo[8].y, khi[8].x, khi[8].y}), ones, accN, 0, 0, 0);
            }
            if (fr == 0) *(LAS f32x4*)(LF + MF_NV + 16 * w + 4 * g) = accN;
            }
            mrun = blast + Mlast;
            WG_BAR();
            { ML_OPAQUE();
#pragma unroll
              for (int j = 0; j < 2; ++j) { const int item = tid + NWAVES * 64 * j; const int t = item >> 4, c = item & 15;
                const f32x4 h0 = *(const LAS f32x4*)(L + M2_HT + t * M2_HTS + c * 32), h1 = *(const LAS f32x4*)(L + M2_HT + t * M2_HTS + c * 32 + 16);
                float ss = (h0[0] * h0[0] + h0[1] * h0[1]) + (h0[2] * h0[2] + h0[3] * h0[3]) + (h1[0] * h1[0] + h1[1] * h1[1]) + (h1[2] * h1[2] + h1[3] * h1[3]);
                ss = grp16_sum(ss);
                const float rn = 1.0f / sqrtf(ss * (1.f / 128) + RMS_EPS);
                const v4u og = og2[j]; v4u o;
                o.x = pk2(h0[0] * rn * gn[0][0] * sigmoidf_(bflo(og[0])), h0[1] * rn * gn[0][1] * sigmoidf_(bfhi(og[0])));
                o.y = pk2(h0[2] * rn * gn[0][2] * sigmoidf_(bflo(og[1])), h0[3] * rn * gn[0][3] * sigmoidf_(bfhi(og[1])));
                o.z = pk2(h1[0] * rn * gn[1][0] * sigmoidf_(bflo(og[2])), h1[1] * rn * gn[1][1] * sigmoidf_(bfhi(og[2])));
                o.w = pk2(h1[2] * rn * gn[1][2] * sigmoidf_(bflo(og[3])), h1[3] * rn * gn[1][3] * sigmoidf_(bfhi(og[3])));
                st16_wt(CAT, (unsigned)((size_t)M * 1024 * 2), ((m0 + t) * 1024 + 512 + hh * 128 + 8 * c) * 2, o); } }
        }
        WG_BAR();
    }
#undef M2_PREFETCH
#undef ML_OPAQUE
}

constexpr int G1_RAWK = 0, G1_KWN = 35840, G1_VN = 72704, G1_W = 109568, G1_CW = 110592, G1_RAWQ = 113152, G1_RAWQS = 256;
static_assert(G1_CW + 5 * 128 * 4 <= G1_RAWQ && G1_RAWQ + 131 * G1_RAWQS <= LDSCTL_OFF && ML_NC == 4, "pass-1 LDS map");
__device__ __forceinline__ void mlstm_pass1(Frame& F, const bf16* XIN, const float* gates, bf16* QKc) {
    LAS unsigned char* L = F.lds + RING_OFF; LAS float* WL = (LAS float*)(L + G1_W); LAS float* CW = (LAS float*)(L + G1_CW);
    float* STC = (float*)(F.ws + WS_STC); float* STN = (float*)(F.ws + WS_STN); float* STS = (float*)(F.ws + WS_STS);
    const int lane0 = F.lane, w = F.wave, tid0 = F.tid;
#define G1_OPAQUE() int lane = lane0, tid = tid0; asm volatile("" : "+v"(lane), "+v"(tid)); const int fr = lane & 15, g = lane >> 4; (void)fr; (void)g; (void)tid
    for (int unit = F.vcu; unit < ML_UNITS; unit += F.G) {
        G1_OPAQUE();
        const int bh = unit / ML_G, grp = unit % ML_G; const int b = bh >> 2, hh = bh & 3; const int t0 = grp * 256; const size_t m0 = (size_t)b * SEQ + t0;
        v4u rk[5], rq[5], rv[4];
#define G1_PREFETCH(st_) do { _Pragma("unroll") for (int j = 0; j < 5; ++j) { const int ridx = tid + NWAVES * 64 * j; const int rrow = ridx >> 4, c = ridx & 15; const int tp = t0 + 128 * (st_) - 3 + rrow; \
            rk[j] = (v4u){0u, 0u, 0u, 0u}; rq[j] = (v4u){0u, 0u, 0u, 0u}; if (ridx < 131 * 16 && tp >= 0) { const bf16* row = XIN + (size_t)(b * SEQ + tp) * NIN + hh * 128 + 8 * c; rk[j] = *(const v4u*)(row + C_KM); rq[j] = *(const v4u*)(row + C_QM); } } \
        _Pragma("unroll") for (int j = 0; j < 4; ++j) { const int item = tid + NWAVES * 64 * j; rv[j] = *(const v4u*)(XIN + (m0 + 128 * (st_) + (item >> 4)) * NIN + C_VM + hh * 128 + 8 * (item & 15)); } } while (0)
        G1_PREFETCH(0);
        for (int idx = tid; idx < 640; idx += NWAVES * 64) { const int j = idx >> 7, cl = idx & 127; CW[idx] = j < 4 ? F.w_conv[j * 1024 + 512 + hh * 128 + cl] : F.b_conv[512 + hh * 128 + cl]; }
        float u4[4]; float carry = 0.f, umax = -INFINITY;
#pragma unroll
        for (int j = 0; j < 4; ++j) { const float lf = gates[(m0 + 64 * j + lane) * 8 + 4 + hh], li = gates[(m0 + 64 * j + lane) * 8 + hh];
            const float bc = wave_scan_sum(lf, lane) + carry; carry = lane_bcast(bc, 63); u4[j] = li - bc; umax = fmaxf(umax, u4[j]); }
        umax = fmaxf(umax, dppf_old<DPP_X1>(umax, umax)); umax = fmaxf(umax, dppf_old<DPP_X2>(umax, umax)); umax = fmaxf(umax, dppf_old<DPP_HMIR>(umax, umax)); umax = fmaxf(umax, dppf_old<DPP_MIR>(umax, umax));
        umax = max_x32(max_x16(umax));
        if (w == 0) {
#pragma unroll
            for (int j = 0; j < 4; ++j) WL[64 * j + lane] = __expf(u4[j] - umax); }
        const float Bg = carry, mg = carry + umax;
        f32x4 accC[8], accN;
#pragma unroll
        for (int dt = 0; dt < 8; ++dt) accC[dt] = (f32x4){0.f, 0.f, 0.f, 0.f};
        accN = (f32x4){0.f, 0.f, 0.f, 0.f};
        const bf16x8 ones = __builtin_bit_cast(bf16x8, (v4u){0x3f803f80u, 0x3f803f80u, 0x3f803f80u, 0x3f803f80u});
#pragma unroll 1
        for (int st = 0; st < 2; ++st) {
            { G1_OPAQUE();
#pragma unroll
            for (int j = 0; j < 5; ++j) { const int ridx = tid + NWAVES * 64 * j; if (ridx < 131 * 16) { *(LAS v4u*)(L + G1_RAWK + (ridx >> 4) * ML_RAWS + (ridx & 15) * 16) = rk[j]; *(LAS v4u*)(L + G1_RAWQ + (ridx >> 4) * G1_RAWQS + (ridx & 15) * 16) = rq[j]; } }
#pragma unroll
            for (int j = 0; j < 4; ++j) { const int item = tid + NWAVES * 64 * j; *(LAS v4u*)(L + G1_VN + (item >> 4) * ML_RS + (item & 15) * 16) = rv[j]; }
            if (st == 0) G1_PREFETCH(1);
            }
            WG_BAR();
            { G1_OPAQUE();
            { const int c = tid & 15;
              f32x4 qw[5][2];
#pragma unroll
              for (int j = 0; j < 4; ++j) { qw[j][0] = *(const f32x4*)(F.w_conv + j * 1024 + hh * 128 + 8 * c); qw[j][1] = *(const f32x4*)(F.w_conv + j * 1024 + hh * 128 + 8 * c + 4); }
              qw[4][0] = *(const f32x4*)(F.b_conv + hh * 128 + 8 * c); qw[4][1] = *(const f32x4*)(F.b_conv + hh * 128 + 8 * c + 4);
#pragma unroll 2
              for (int it = 0; it < 4; ++it) { const int s = (tid >> 4) + 32 * it;
                float y[8] = {qw[4][0][0], qw[4][0][1], qw[4][0][2], qw[4][0][3], qw[4][1][0], qw[4][1][1], qw[4][1][2], qw[4][1][3]};
#pragma unroll
                for (int j = 0; j < 4; ++j) { const v4u x = *(const LAS v4u*)(L + G1_RAWQ + (s + j) * G1_RAWQS + c * 16);
                    y[0] += qw[j][0][0] * bflo(x[0]); y[1] += qw[j][0][1] * bfhi(x[0]); y[2] += qw[j][0][2] * bflo(x[1]); y[3] += qw[j][0][3] * bfhi(x[1]);
                    y[4] += qw[j][1][0] * bflo(x[2]); y[5] += qw[j][1][1] * bfhi(x[2]); y[6] += qw[j][1][2] * bflo(x[3]); y[7] += qw[j][1][3] * bfhi(x[3]); }
                v4u o;
#pragma unroll
                for (int e = 0; e < 4; ++e) { float q0 = y[2 * e], q1 = y[2 * e + 1];
                    q0 = q0 * __builtin_amdgcn_rcpf(1.0f + __builtin_amdgcn_exp2f(-1.44269504089f * q0)); q1 = q1 * __builtin_amdgcn_rcpf(1.0f + __builtin_amdgcn_exp2f(-1.44269504089f * q1)); o[e] = pk2(q0, q1); }
                st16_wt(QKc, (unsigned)((size_t)M * 1024 * 2), ((m0 + 128 * st + s) * 1024 + hh * 128 + 8 * c) * 2, o); } }
            { const int c = tid & 15;
              f32x4 cw[5][2];
#pragma unroll
              for (int j = 0; j < 5; ++j) { cw[j][0] = *(const LAS f32x4*)(CW + j * 128 + 8 * c); cw[j][1] = *(const LAS f32x4*)(CW + j * 128 + 8 * c + 4); }
#pragma unroll 2
              for (int it = 0; it < 4; ++it) { const int s = (tid >> 4) + 32 * it;
                const float wsc = WL[128 * st + s];
                float y[8] = {cw[4][0][0], cw[4][0][1], cw[4][0][2], cw[4][0][3], cw[4][1][0], cw[4][1][1], cw[4][1][2], cw[4][1][3]};
#pragma unroll
                for (int j = 0; j < 4; ++j) { const v4u x = *(const LAS v4u*)(L + G1_RAWK + (s + j) * ML_RAWS + c * 16);
                    y[0] += cw[j][0][0] * bflo(x[0]); y[1] += cw[j][0][1] * bfhi(x[0]); y[2] += cw[j][0][2] * bflo(x[1]); y[3] += cw[j][0][3] * bfhi(x[1]);
                    y[4] += cw[j][1][0] * bflo(x[2]); y[5] += cw[j][1][1] * bfhi(x[2]); y[6] += cw[j][1][2] * bflo(x[3]); y[7] += cw[j][1][3] * bfhi(x[3]); }
                v4u o, ow;
#pragma unroll
                for (int e = 0; e < 4; ++e) { float k0 = y[2 * e], k1 = y[2 * e + 1];
                    k0 = k0 * __builtin_amdgcn_rcpf(1.0f + __builtin_amdgcn_exp2f(-1.44269504089f * k0)) * K_SCALE; k1 = k1 * __builtin_amdgcn_rcpf(1.0f + __builtin_amdgcn_exp2f(-1.44269504089f * k1)) * K_SCALE;
                    o[e] = pk2(k0, k1); ow[e] = pk2(k0 * wsc, k1 * wsc); }
                *(LAS v4u*)(L + G1_KWN + s * ML_RS + c * 16) = ow;
                st16_wt(QKc, (unsigned)((size_t)M * 1024 * 2), ((m0 + 128 * st + s) * 1024 + 512 + hh * 128 + 8 * c) * 2, o); } }
            }
            WG_BAR();
            { G1_OPAQUE();
            const LAS unsigned char* kp = L + G1_KWN + (8 * g + (fr >> 2)) * ML_RS + 4 * (fr & 3) * 2;
#pragma unroll
            for (int ks = 0; ks < 4; ++ks) {
                const LAS unsigned char* vp = L + G1_VN + (32 * ks + 8 * g + (fr >> 2)) * ML_RS + (16 * w + 4 * (fr & 3)) * 2;
                const v2u vlo = lds_tr16(vp), vhi = lds_tr16(vp + 4 * ML_RS); const bf16x8 vfrag = __builtin_bit_cast(bf16x8, (v4u){vlo.x, vlo.y, vhi.x, vhi.y});
#pragma unroll
                for (int dt = 0; dt < 8; ++dt) { const v2u lo = lds_tr16(kp + 32 * ks * ML_RS + 32 * dt), hi = lds_tr16(kp + (32 * ks + 4) * ML_RS + 32 * dt);
                    accC[dt] = __builtin_amdgcn_mfma_f32_16x16x32_bf16(__builtin_bit_cast(bf16x8, (v4u){lo.x, lo.y, hi.x, hi.y}), vfrag, accC[dt], 0, 0, 0); }
                const v2u lo = lds_tr16(kp + 32 * ks * ML_RS + 32 * w), hi = lds_tr16(kp + (32 * ks + 4) * ML_RS + 32 * w);
                accN = __builtin_amdgcn_mfma_f32_16x16x32_bf16(__builtin_bit_cast(bf16x8, (v4u){lo.x, lo.y, hi.x, hi.y}), ones, accN, 0, 0, 0);
            }
            }
            WG_BAR();
        }
#pragma unroll
        for (int dt = 0; dt < 8; ++dt) st16_wt(STC, (unsigned)((size_t)ML_UNITS * 16384 * 4), ((size_t)unit * 16384 + ((w * 8 + dt) * 64 + lane) * 4) * 4, __builtin_bit_cast(v4u, accC[dt]));
        if (fr == 0) *(f32x4*)(STN + unit * 128 + 16 * w + 4 * g) = accN;
        if (tid == 0) { STS[unit * 4] = mg; STS[unit * 4 + 1] = Bg; }
#undef G1_PREFETCH
    }
#undef G1_OPAQUE
}
__device__ __forceinline__ void mlstm_scan(Frame& F) {
    float* STC = (float*)(F.ws + WS_STC); float* STN = (float*)(F.ws + WS_STN); float* STS = (float*)(F.ws + WS_STS);
    const int n = 8 * (16384 + 128), stride = F.G * NWAVES * 64;
    for (int idx = (int)blockIdx.x * NWAVES * 64 + F.tid; idx < n; idx += stride) {
        const int bh = idx / (16384 + 128), el = idx % (16384 + 128);
        float m = 0.f, val = 0.f;
        float* const pb = el < 16384 ? STC + (size_t)bh * ML_G * 16384 + el : STN + bh * ML_G * 128 + (el - 16384);
        const int pstr = el < 16384 ? 16384 : 128;
        float xs[ML_G], mgs[ML_G], bgs[ML_G];
#pragma unroll
        for (int gi = 0; gi < ML_G; ++gi) { xs[gi] = pb[(size_t)gi * pstr]; mgs[gi] = STS[(bh * ML_G + gi) * 4]; bgs[gi] = STS[(bh * ML_G + gi) * 4 + 1]; }
#pragma unroll
        for (int gi = 0; gi < ML_G; ++gi) { const int unit = bh * ML_G + gi;
            pb[(size_t)gi * pstr] = val; if (el == 0) STS[unit * 4 + 2] = m;
            const float mn = fmaxf(bgs[gi] + m, mgs[gi]);
            val = __expf(bgs[gi] + m - mn) * val + __expf(mgs[gi] - mn) * xs[gi]; m = mn; }
    }
}
#ifndef P6_ALIGN
#define P6_ALIGN true
#endif
#ifndef P2_ALIGN
#define P2_ALIGN true
#endif
#ifndef GB_MODE
#define GB_MODE 0
#endif
#ifndef REP_LW
#define REP_LW 1
#endif
#ifndef REP_P7
#define REP_P7 1
#endif
#ifndef REP_FB
#define REP_FB 1
#endif
#ifndef REP_BAR_MODE
#define REP_BAR_MODE 0
#endif
#ifndef REP_BAR
#define REP_BAR 0
#endif
#ifndef REP_P0
#define REP_P0 1
#endif
#ifndef REP_P1
#define REP_P1 1
#endif
#ifndef REP_P2
#define REP_P2 1
#endif
#ifndef REP_ML1
#define REP_ML1 1
#endif
#ifndef REP_ATT
#define REP_ATT 1
#endif
#ifndef REP_CMB
#define REP_CMB 1
#endif
#ifndef REP_ML2
#define REP_ML2 1
#endif
#ifndef REP_P4
#define REP_P4 1
#endif
#ifndef REP_P5
#define REP_P5 1
#endif
#ifndef REP_P6
#define REP_P6 1
#endif
struct Args { const float* in[18]; float* out; unsigned char* ws; int ph_lo, ph_hi, li, pad; };
__global__ void __launch_bounds__(NWAVES * 64, 2) blk_fwd(Args args) {
    extern __shared__ __attribute__((aligned(16))) unsigned char lds[];
    Frame F;
    F.lds = (LAS unsigned char*)lds;
    F.MISC = (volatile LAS unsigned*)(F.lds + MISC_OFF);
    F.tid = threadIdx.x; F.lane = F.tid & 63; F.wave = __builtin_amdgcn_readfirstlane(F.tid >> 6);
    F.G = gridDim.x; { const int bx = blockIdx.x; F.vcu = (F.G % 8 == 0) ? (bx % 8) * (F.G / 8) + bx / 8 : bx; }
    unsigned char* ws = args.ws; F.ws = ws;
    F.ctl = (gu32*)(ws + WS_CTL);
    F.x = args.in[0]; F.c = args.in[1]; F.g_mix = args.in[2]; F.w_in = args.in[3]; F.w_conv = args.in[4]; F.b_conv = args.in[5]; F.b_ig = args.in[6]; F.b_fg = args.in[7];
    F.qn_g = args.in[8]; F.kn_g = args.in[9]; F.mn_g = args.in[10]; F.w_out = args.in[11]; F.g_ffn = args.in[12]; F.w_gate = args.in[13]; F.w_up = args.in[14]; F.w_down = args.in[15];
    F.w_ada = args.in[16]; F.b_ada = args.in[17]; F.out = args.out;
    for (int u = F.tid; u < (LDS_BYTES - LDSCTL_OFF) / 4; u += NWAVES * 64) ((LAS unsigned*)(F.lds + LDSCTL_OFF))[u] = 0u;
    __syncthreads();
    const int lo = args.ph_lo, hi = args.ph_hi;
    XcdBarrier bar; bar.bar = (unsigned*)(F.ctl + CW_BAR) + args.li * XCD_BAR_WORDS; bar.x = 0; bar.st = nullptr;
    if (hi - lo > 1) bar = xcd_barrier_post((unsigned*)(F.ctl + CW_BAR) + args.li * XCD_BAR_WORDS, F.MISC + 8);
#define IN(k) (lo <= (k) && (k) < hi)
#define BOTH(k) (IN(k) && IN((k) + 1))
#define GRID_BAR() xcd_barrier<GB_MODE>(bar)
    bf16* Win_t = (bf16*)(ws + WS_WIN); bf16* Wout_t = (bf16*)(ws + WS_WOUT); bf16* Wgu_t = (bf16*)(ws + WS_WGU); bf16* Wdn_t = (bf16*)(ws + WS_WDN);
    bf16* XN = (bf16*)(ws + WS_XN); bf16* XIN = (bf16*)(ws + WS_XIN); bf16* CAT = (bf16*)(ws + WS_CAT); bf16* HB = (bf16*)(ws + WS_H);
    float* mod = (float*)(ws + WS_MOD); float* gates = (float*)(ws + WS_GATES); bf16* X1B = (bf16*)(ws + WS_X1B);

    if (IN(0)) { for (int rep = 0; rep < REP_P0; ++rep) p0_prologue(F); if (BOTH(0)) GRID_BAR(); }
    for (int rep = 0; rep < REP_BAR; ++rep) xcd_barrier<REP_BAR_MODE>(bar);
    if (IN(1)) { p0_win_copy(F); __syncthreads(); for (int rep = 0; rep < REP_P1; ++rep) { norm_rows<true>(F, F.x, F.g_mix, mod + 0 * D, mod + 1 * D, XN, gates); __syncthreads(); } if (BOTH(1)) GRID_BAR(); }
    if (IN(2)) {
        pg8::Gemm g{XN, Win_t, M, NIN, D}; pg8::StaticOrder S; S.init(M, NIN, F.G, (int)blockIdx.x);
        pg8::EpiBf16 E{XIN, NIN, (unsigned)((size_t)M * NIN * 2)};
        for (int rep = 0; rep < REP_P2; ++rep) pg8::gemm_phase<pg8::EpiBf16, pg8::StaticOrder, P2_ALIGN, true>(F.lds + RING_OFF, g, S, E);
        { const int nu = (M / 256) * (NIN / 256); const int first = (nu % F.G) ? (nu % F.G) : 0; __syncthreads(); for (int rep = 0; rep < REP_LW; ++rep) p0_late_weights(F, first); }
        if (BOTH(2)) GRID_BAR();
    }
    if (IN(3)) {
        if (__builtin_amdgcn_readfirstlane((int)threadIdx.x) >= 256) __builtin_amdgcn_s_setprio(1);
        bf16* OP = (bf16*)F.out; float* LSE = (float*)((unsigned char*)F.out + 48 * MiB);
        for (int rep = 0; rep < REP_ML1; ++rep) mlstm_pass1(F, XIN, gates, XN);
        for (int rep = 0; rep < REP_ATT; ++rep) attn_phase<false>(F, XIN, OP, LSE, CAT, 1024, AT_UNITS);
        GRID_BAR();
        mlstm_scan(F);
        for (int rep = 0; rep < REP_CMB; ++rep) attn_phase<true>(F, XIN, OP, LSE, CAT, 0, 1024);
        GRID_BAR();
        for (int rep = 0; rep < REP_ML2; ++rep) mlstm_pass2(F, XIN, XN, gates, CAT);
        __builtin_amdgcn_s_setprio(0);
        if (BOTH(3)) GRID_BAR();
    }
    if (IN(4)) {
        pg8::Gemm g{CAT, Wout_t, M, D, D}; pg8::StaticOrder S; S.init(M, D, F.G, (int)blockIdx.x);
        pg8::EpiResToB16 E{F.x, X1B, D, mod + 2 * D, NMOD, SEQ, (size_t)M * D * 2};
        for (int rep = 0; rep < REP_P4; ++rep) pg8::gemm_phase<pg8::EpiResToB16, pg8::StaticOrder, true, true>(F.lds + RING_OFF, g, S, E);
        if (BOTH(4)) GRID_BAR();
    }
    if (IN(5)) { for (int rep = 0; rep < REP_P5; ++rep) norm_rows<false, true>(F, (const float*)X1B, F.g_ffn, mod + 3 * D, mod + 4 * D, XN, nullptr); if (BOTH(5)) GRID_BAR(); }
    if (IN(6)) {
        pg8::Gemm g{XN, Wgu_t, M, NGU, D}; pg8::StaticOrder S; S.init(M, NGU, F.G, (int)blockIdx.x, true);
        pg8::EpiSwiGLU E{HB, FF, (unsigned)((size_t)M * FF * 2)};
        for (int rep = 0; rep < REP_P6; ++rep) pg8::gemm_phase<pg8::EpiSwiGLU, pg8::StaticOrder, P6_ALIGN, true>(F.lds + RING_OFF, g, S, E);
        if (BOTH(6)) GRID_BAR();
    }
    if (IN(7)) {
        pg8::Gemm g{HB, Wdn_t, M, D, FF}; pg8::StaticOrder S; S.init(M, D, F.G, (int)blockIdx.x);
        pg8::EpiResFromB16 E{X1B, F.out, D, mod + 5 * D, NMOD, SEQ};
        for (int rep = 0; rep < REP_P7; ++rep) pg8::gemm_phase<pg8::EpiResFromB16, pg8::StaticOrder, true, true>(F.lds + RING_OFF, g, S, E);
    }
#undef IN
#undef BOTH
}

extern "C" void kernel_launch(void* const* d_in, const int* in_sizes, int n_in, void* d_out, int out_size, void* d_ws, size_t ws_size, hipStream_t stream) {
    static int grid = 0;
    if (grid == 0) {
        if (n_in != 18 || out_size != M * D || ws_size < WS_END) { fprintf(stderr, "kernel_launch: unexpected shapes n_in %d out %d ws %zu\n", n_in, out_size, ws_size); grid = -1; return; }
        int dev = 0, cus = 0;
        if (hipGetDevice(&dev) != hipSuccess || hipDeviceGetAttribute(&cus, hipDeviceAttributeMultiprocessorCount, dev) != hipSuccess) { grid = -1; return; }
        if (hipFuncSetAttribute((const void*)blk_fwd, hipFuncAttributeMaxDynamicSharedMemorySize, LDS_BYTES) != hipSuccess) { fprintf(stderr, "kernel_launch: hipFuncSetAttribute failed\n"); grid = -1; return; }
        int per_cu = 0;
        if (hipOccupancyMaxActiveBlocksPerMultiprocessor(&per_cu, (const void*)blk_fwd, NWAVES * 64, LDS_BYTES) != hipSuccess || per_cu < 1) { fprintf(stderr, "kernel_launch: occupancy query reports %d workgroups per CU; nothing launched\n", per_cu); (void)hipGetLastError(); grid = -1; return; }
        grid = cus;
    }
    if (grid < 0) return;
    (void)hipMemsetAsync((char*)d_ws + WS_CTL, 0, CTL_ZERO_BYTES, stream);
    Args a{};
    for (int i = 0; i < 18; ++i) a.in[i] = (const float*)d_in[i];
    a.out = (float*)d_out; a.ws = (unsigned char*)d_ws;
    int li = 0;
    auto run = [&](int lo, int hi) { a.ph_lo = lo; a.ph_hi = hi; a.li = li++; hipLaunchKernelGGL(blk_fwd, dim3(grid), dim3(NWAVES * 64), LDS_BYTES, stream, a); };
    run(0, 8);
}
```

```cpp
#include <hip/hip_runtime.h>
#include <cstdio>
#include <cstdint>

namespace pg8 {
#define PG8_LAS __attribute__((address_space(3)))
typedef unsigned short bf16_t;
typedef short bf16x8 __attribute__((ext_vector_type(8)));
typedef float f32x4 __attribute__((ext_vector_type(4)));
typedef unsigned u32x4 __attribute__((ext_vector_type(4)));
constexpr int BM = 256, BK = 64, HALF = 128, HTB = HALF * BK * 2  , STAGE_BYTES = 8 * HTB, NXCD = 8, WGM = 8;

__host__ __device__ __forceinline__ int lds_byte(int r, int c) { const int st = (r >> 4) * 2 + (c >> 5), rr = r & 15, cc = c & 31, ob = rr * 64 + cc * 2; return st * 1024 + (ob ^ (((ob >> 9) & 1) << 5)); }
__host__ __device__ __forceinline__ void stage_rc(int b, int& R, int& C) { const int st = b / 1024, sb = b % 1024, swz = sb ^ (((sb >> 9) & 1) << 5); R = (st >> 1) * 16 + swz / 64; C = (st & 1) * 32 + (swz % 64) / 2; }
__host__ __device__ __forceinline__ int perm32(int rho) { const int n = rho >> 4, i = rho & 15; return 8 * (i >> 2) + 4 * n + (i & 3); }

struct Unit { int pm, pn, half; };
struct Gemm { const bf16_t* A; const bf16_t* Bt; int M, N, K; };

struct StaticOrder {
    int nM, nN, nwg, G, c; bool half_tail;
    __host__ __device__ void init(int M, int N, int G_, int c_, bool half_tail_ = false) { nM = M / BM; nN = N / BM; nwg = nM * nN; G = G_; c = c_; half_tail = half_tail_ && (nwg % G_) * 2 == G_; }
    __host__ __device__ bool next(int i, Unit& u) const {
        long L = (long)i * G + c; u.half = -1;
        if (half_tail && L >= (long)(nwg / G) * G) { if (i > nwg / G) return false; L = (long)(nwg / G) * G + (c >> 1); u.half = c & 1; }
        if (L >= nwg) return false;
        int wgid = (int)L; { const int q = nwg / NXCD, r = nwg % NXCD, xcd = wgid % NXCD, off = wgid / NXCD; wgid = (xcd < r ? xcd * (q + 1) : r * (q + 1) + (xcd - r) * q) + off; }
        const int nig = WGM * nN, gid = wgid / nig, fm = gid * WGM, gsz = (nM - fm) < WGM ? (nM - fm) : WGM;
        u.pm = fm + ((wgid % nig) % gsz); u.pn = (wgid % nig) / gsz; return true;
    }
    __device__ __forceinline__ void a_ready(const Unit&) const {}
    __device__ __forceinline__ void done(const Unit&) const {}
};

__device__ __forceinline__ unsigned cvt_pk_bf16(float lo, float hi) { unsigned r; asm volatile("v_cvt_pk_bf16_f32 %0, %1, %2" : "=v"(r) : "v"(lo), "v"(hi)); return r; }
typedef float f32x2 __attribute__((ext_vector_type(2)));
struct EpiBf16 {
    static constexpr bool PERM = true, AFTER_DRAIN = false;
    bf16_t* O; int ldc; unsigned obytes;
    __device__ __forceinline__ void operator()(const f32x4 (&acc)[2][2][4][2], const Unit& u, int wr, int wc, int fr, int fq) const {
        const int row0 = u.pm * BM + wr * 64 + fr; const int col0 = u.pn * BM + wc * 32 + 8 * fq;
        const __amdgpu_buffer_rsrc_t rs = __builtin_amdgcn_make_buffer_rsrc(O, 0, obytes, 0x00020000);
#pragma unroll
        for (int ai = 0; ai < 2; ++ai)
#pragma unroll
            for (int m = 0; m < 4; ++m) { const unsigned voff = (unsigned)(((size_t)(row0 + ai * HALF + m * 16) * ldc + col0) * 2);
#pragma unroll
                for (int bj = 0; bj < 2; ++bj) { const f32x4 v0 = acc[ai][bj][m][0], v1 = acc[ai][bj][m][1];
                    u32x4 w; w.x = cvt_pk_bf16(v0[0], v0[1]); w.y = cvt_pk_bf16(v0[2], v0[3]); w.z = cvt_pk_bf16(v1[0], v1[1]); w.w = cvt_pk_bf16(v1[2], v1[3]);
                    __builtin_amdgcn_raw_buffer_store_b128(w, rs, voff + bj * HALF * 2, 0, 16); } }
    }
};
__device__ __forceinline__ float silu_f(float x) { return x * __builtin_amdgcn_rcpf(1.0f + __builtin_amdgcn_exp2f(-1.44269504089f * x)); }
struct EpiSwiGLU {
    static constexpr bool PERM = true, AFTER_DRAIN = false;
    bf16_t* O; int ldc; unsigned obytes;
    __device__ __forceinline__ void operator()(const f32x4 (&acc)[2][2][4][2], const Unit& u, int wr, int wc, int fr, int fq) const {
        const int row0 = u.pm * BM + (u.half > 0 ? HALF : 0) + wr * 64 + fr; const int col0 = u.pn * HALF + wc * 32 + 8 * fq;
        const __amdgpu_buffer_rsrc_t rs = __builtin_amdgcn_make_buffer_rsrc(O, 0, obytes, 0x00020000);
#pragma unroll
        for (int ai = 0; ai < 2; ++ai) { if (ai == 1 && u.half >= 0) break;
#pragma unroll
            for (int m = 0; m < 4; ++m) { const unsigned voff = (unsigned)(((size_t)(row0 + ai * HALF + m * 16) * ldc + col0) * 2);
                const f32x4 g0 = acc[ai][0][m][0], g1 = acc[ai][0][m][1], u0 = acc[ai][1][m][0], u1 = acc[ai][1][m][1];
                u32x4 w; w.x = cvt_pk_bf16(silu_f(g0[0]) * u0[0], silu_f(g0[1]) * u0[1]); w.y = cvt_pk_bf16(silu_f(g0[2]) * u0[2], silu_f(g0[3]) * u0[3]);
                w.z = cvt_pk_bf16(silu_f(g1[0]) * u1[0], silu_f(g1[1]) * u1[1]); w.w = cvt_pk_bf16(silu_f(g1[2]) * u1[2], silu_f(g1[3]) * u1[3]);
                __builtin_amdgcn_raw_buffer_store_b128(w, rs, voff, 0, 16); } }
    }
};
template <class Epi, class Sched, bool ALIGN_EPI = false, bool SP2 = false>
__device__ __forceinline__ void gemm_phase(PG8_LAS unsigned char* lds, const Gemm g, const Sched& S, const Epi& E) {
    const int tid = threadIdx.x, wid = __builtin_amdgcn_readfirstlane(tid >> 6), lane = tid & 63, wr = wid >> 2, wc = wid & 3, fr = lane & 15, fq = lane >> 4;
    const int K = g.K, nt = K / BK;
    unsigned voffA[2], voffB[2];
#pragma unroll
    for (int i = 0; i < 2; ++i) { int R, C; stage_rc(tid * 16 + i * 8192, R, C); const int Rb = Epi::PERM ? ((R & ~31) + perm32(R & 31)) : R;
        voffA[i] = (unsigned)(R * K + C) * 2u; voffB[i] = (unsigned)(Rb * K + C) * 2u; }
    const size_t kstep = (size_t)(BK * 2);
    const size_t hstep = (size_t)HALF * K * 2;
    const size_t tstep = 2 * hstep;
    const unsigned ldsw = (unsigned)wid * 1024u;
    const int aoff = lds_byte(wr * 64 + fr, fq * 8), boff = lds_byte(wc * 32 + fr, fq * 8);
#define PG8_SA(b, h) (((b) * 2 + (h)) * HTB)
#define PG8_SB(b, h) ((4 + (b) * 2 + (h)) * HTB)
#define PG8_STAGE(bufoff, gbase, voff) do { _Pragma("unroll") for (int _i = 0; _i < 2; ++_i) \
        __builtin_amdgcn_global_load_lds((const unsigned*)((const char*)(gbase) + (voff)[_i]), (PG8_LAS unsigned*)(lds + (bufoff) + ldsw + _i * 8192), 16, 0, 0); } while (0)
#define PG8_LDA(dst, b, h) do { _Pragma("unroll") for (int m = 0; m < 4; ++m) _Pragma("unroll") for (int k = 0; k < 2; ++k) dst[m][k] = *(const PG8_LAS bf16x8*)(lds + PG8_SA(b, h) + aoff + m * 2048 + k * 1024); } while (0)
#define PG8_LDB(dst, b, h) do { _Pragma("unroll") for (int n = 0; n < 2; ++n) _Pragma("unroll") for (int k = 0; k < 2; ++k) dst[n][k] = *(const PG8_LAS bf16x8*)(lds + PG8_SB(b, h) + boff + n * 2048 + k * 1024); } while (0)
#define PG8_MMA(ai, bj, At, Bt) do { __builtin_amdgcn_s_setprio(1); _Pragma("unroll") for (int m = 0; m < 4; ++m) _Pragma("unroll") for (int n = 0; n < 2; ++n) _Pragma("unroll") for (int k = 0; k < 2; ++k) \
        acc[ai][bj][m][n] = __builtin_amdgcn_mfma_f32_16x16x32_bf16(Bt[n][k], At[m][k], acc[ai][bj][m][n], 0, 0, 0); __builtin_amdgcn_s_setprio(0); } while (0)
#define PG8_WAIT_V(n) asm volatile("s_waitcnt vmcnt(" #n ")" ::: "memory")
#define PG8_WAIT_L(n) asm volatile("s_waitcnt lgkmcnt(" #n ")" ::: "memory")
#define PG8_BAR __builtin_amdgcn_s_barrier()
#define PG8_SCHED __builtin_amdgcn_sched_barrier(0)
    Unit cur, nxt; int ui = 0;
    if (!S.next(0, cur)) return;
    f32x4 acc[2][2][4][2];
#pragma unroll
    for (int a = 0; a < 2; ++a)
#pragma unroll
        for (int b = 0; b < 2; ++b)
#pragma unroll
            for (int m = 0; m < 4; ++m)
#pragma unroll
                for (int n = 0; n < 2; ++n) acc[a][b][m][n] = (f32x4){0.f, 0.f, 0.f, 0.f};
    bf16x8 At[4][2], B0[2][2], B1[2][2];
    const char* cA = (const char*)g.A + (size_t)cur.pm * tstep + (cur.half > 0 ? hstep : 0); const char* cB = (const char*)g.Bt + (size_t)cur.pn * tstep;
    size_t hsAc = cur.half >= 0 ? 0 : hstep;
    S.a_ready(cur);
    if constexpr (SP2) {
        PG8_STAGE(PG8_SB(0, 0), cB, voffB); PG8_STAGE(PG8_SB(0, 1), cB + hstep, voffB); PG8_STAGE(PG8_SA(0, 0), cA, voffA); PG8_STAGE(PG8_SA(0, 1), cA + hsAc, voffA);
        if (wr == 1) PG8_BAR;
        PG8_WAIT_V(2); PG8_BAR;
        PG8_STAGE(PG8_SB(1, 0), cB + kstep, voffB); PG8_STAGE(PG8_SA(1, 0), cA + kstep, voffA); PG8_STAGE(PG8_SB(1, 1), cB + hstep + kstep, voffB);
        PG8_WAIT_V(6); PG8_BAR;
    } else {
        PG8_STAGE(PG8_SB(0, 0), cB, voffB); PG8_STAGE(PG8_SA(0, 0), cA, voffA); PG8_STAGE(PG8_SB(0, 1), cB + hstep, voffB); PG8_STAGE(PG8_SA(0, 1), cA + hstep, voffA);
        if (wr == 1) PG8_BAR;
        PG8_WAIT_V(4); PG8_BAR;
        PG8_STAGE(PG8_SB(1, 0), cB + kstep, voffB); PG8_STAGE(PG8_SA(1, 0), cA + kstep, voffA); PG8_STAGE(PG8_SB(1, 1), cB + hstep + kstep, voffB);
        PG8_WAIT_V(6); PG8_BAR;
    }
    for (;;) {
        const bool has_next = S.next(ui + 1, nxt);
        const char* nA = has_next ? (const char*)g.A + (size_t)nxt.pm * tstep + (nxt.half > 0 ? hstep : 0) : cA; const char* nB = has_next ? (const char*)g.Bt + (size_t)nxt.pn * tstep : cB;
        const size_t hsAn = has_next ? (nxt.half >= 0 ? 0 : hstep) : hsAc; const bool full = cur.half < 0;
        for (int t = 0; t < nt; t += 2) {
            const bool last = (t == nt - 2);
            const char* a1 = cA + (size_t)(t + 1) * kstep;
            const char* a2 = last ? nA : cA + (size_t)(t + 2) * kstep; const char* b2 = last ? nB : cB + (size_t)(t + 2) * kstep;
            const char* a3 = a2 + kstep; const char* b3 = b2 + kstep;
            if (last && has_next) S.a_ready(nxt);
            if constexpr (SP2) {
            PG8_LDB(B0, 0, 0); PG8_LDB(B1, 0, 1); PG8_SCHED; PG8_LDA(At, 0, 0); PG8_STAGE(PG8_SA(1, 1), a1 + hsAc, voffA);
            PG8_WAIT_V(8); PG8_WAIT_L(0); PG8_BAR; PG8_MMA(0, 0, At, B0); PG8_MMA(0, 1, At, B1); PG8_BAR; PG8_SCHED;
            PG8_LDA(At, 0, 1); PG8_STAGE(PG8_SB(0, 0), b2, voffB); PG8_STAGE(PG8_SB(0, 1), b2 + hstep, voffB); PG8_STAGE(PG8_SA(0, 0), a2, voffA);
            PG8_WAIT_V(8); PG8_WAIT_L(0); PG8_BAR; if (full) { PG8_MMA(1, 0, At, B0); PG8_MMA(1, 1, At, B1); } PG8_BAR; PG8_SCHED;
            PG8_LDB(B0, 1, 0); PG8_LDB(B1, 1, 1); PG8_SCHED; PG8_LDA(At, 1, 0); PG8_STAGE(PG8_SA(0, 1), a2 + (last ? hsAn : hsAc), voffA);
            PG8_WAIT_V(8); PG8_WAIT_L(0); PG8_BAR; PG8_MMA(0, 0, At, B0); PG8_MMA(0, 1, At, B1); PG8_BAR; PG8_SCHED;
            PG8_LDA(At, 1, 1); PG8_STAGE(PG8_SB(1, 0), b3, voffB); PG8_STAGE(PG8_SB(1, 1), b3 + hstep, voffB); PG8_STAGE(PG8_SA(1, 0), a3, voffA);
            PG8_WAIT_V(8); PG8_WAIT_L(0); PG8_BAR; if (full) { PG8_MMA(1, 0, At, B0); PG8_MMA(1, 1, At, B1); } PG8_BAR; PG8_SCHED;
            } else {
            PG8_LDB(B0, 0, 0); PG8_SCHED; PG8_LDA(At, 0, 0); PG8_STAGE(PG8_SA(1, 1), a1 + hstep, voffA);
            PG8_WAIT_L(8); PG8_BAR; PG8_WAIT_L(0); PG8_MMA(0, 0, At, B0); PG8_BAR; PG8_SCHED;
            PG8_LDB(B1, 0, 1); PG8_STAGE(PG8_SB(0, 0), b2, voffB);
            PG8_BAR; PG8_WAIT_L(0); PG8_MMA(0, 1, At, B1); PG8_BAR;
            PG8_LDA(At, 0, 1); PG8_STAGE(PG8_SA(0, 0), a2, voffA);
            PG8_BAR; PG8_WAIT_L(0); PG8_MMA(1, 0, At, B0); PG8_BAR; PG8_SCHED;
            PG8_STAGE(PG8_SB(0, 1), b2 + hstep, voffB);
            PG8_WAIT_V(6); PG8_BAR; PG8_MMA(1, 1, At, B1); PG8_BAR;
            PG8_LDB(B0, 1, 0); PG8_SCHED; PG8_LDA(At, 1, 0); PG8_STAGE(PG8_SA(0, 1), a2 + hstep, voffA);
            PG8_WAIT_L(8); PG8_BAR; PG8_WAIT_L(0); PG8_MMA(0, 0, At, B0); PG8_BAR; PG8_SCHED;
            PG8_LDB(B1, 1, 1); PG8_STAGE(PG8_SB(1, 0), b3, voffB);
            PG8_BAR; PG8_WAIT_L(0); PG8_MMA(0, 1, At, B1); PG8_BAR;
            PG8_LDA(At, 1, 1); PG8_STAGE(PG8_SA(1, 0), a3, voffA);
            PG8_BAR; PG8_WAIT_L(0); PG8_MMA(1, 0, At, B0); PG8_BAR; PG8_SCHED;
            PG8_STAGE(PG8_SB(1, 1), b3 + hstep, voffB);
            PG8_WAIT_V(6); PG8_BAR; PG8_MMA(1, 1, At, B1); PG8_BAR;
            }
        }
        if constexpr (ALIGN_EPI) { if (wr == 0) PG8_BAR; }
        if constexpr (!Epi::AFTER_DRAIN) { E(acc, cur, wr, wc, fr, fq); S.done(cur); }
        if (!has_next) break;
#pragma unroll
        for (int a = 0; a < 2; ++a)
#pragma unroll
            for (int b = 0; b < 2; ++b)
#pragma unroll
                for (int m = 0; m < 4; ++m)
#pragma unroll
                    for (int n = 0; n < 2; ++n) acc[a][b][m][n] = (f32x4){0.f, 0.f, 0.f, 0.f};
        cur = nxt; cA = nA; cB = nB; hsAc = hsAn; ++ui;
        if constexpr (ALIGN_EPI) { if (wr == 1) PG8_BAR; }
    }
    PG8_WAIT_V(0);
    if constexpr (!ALIGN_EPI) { if (wr == 0) PG8_BAR; }
    PG8_BAR;
    if constexpr (Epi::AFTER_DRAIN) { E.fused(acc, cur, wr, wc, fr, fq, lds, wid, lane); S.done(cur); }
#undef PG8_SA
#undef PG8_SB
#undef PG8_STAGE
#undef PG8_LDA
#undef PG8_LDB
#undef PG8_MMA
#undef PG8_WAIT_V
#undef PG8_WAIT_L
#undef PG8_BAR
#undef PG8_SCHED
}
}

constexpr int NWAVES = 8;
constexpr int BATCH = 2, SEQ = 8192, D = 1024, M = BATCH * SEQ;
constexpr int INC = 3592, NIN = 3584, FF = 2816, NGU = 2 * FF, NMOD = 6 * D;
constexpr int C_QA = 0, C_KA = 512, C_VA = 1024, C_QM = 1536, C_KM = 2048, C_VM = 2560, C_OG = 3072;
constexpr float RMS_EPS = 1e-6f;
constexpr size_t MiB = 1u << 20;
constexpr size_t WS_CTL = 0, CTL_ZERO_BYTES = 32 * 1024;
constexpr size_t WS_MOD = 1 * MiB;
constexpr size_t WS_GATES = 1 * MiB + 512 * 1024;
constexpr size_t WS_WIN = 2 * MiB, WS_WOUT = 9 * MiB, WS_WGU = 11 * MiB, WS_WDN = 22 * MiB;
constexpr size_t WS_STC = 28 * MiB, WS_STN = 44 * MiB, WS_STS = 44 * MiB + 512 * 1024;
constexpr size_t WS_XN = 48 * MiB;
constexpr size_t WS_CAT = 80 * MiB;
constexpr size_t WS_XIN = 112 * MiB;
constexpr size_t WS_H = 112 * MiB;
constexpr size_t WS_X1B = 200 * MiB;
constexpr size_t WS_AUX = 232 * MiB;
constexpr size_t WS_END = 256 * MiB;
static_assert(WS_WDN + (size_t)D * FF * 2 <= WS_STC && WS_XIN + (size_t)M * NIN * 2 <= 224 * MiB && WS_H + (size_t)M * FF * 2 <= WS_X1B && WS_X1B + (size_t)M * D * 2 <= WS_AUX, "ws map");
constexpr int CW_TMO = 0, CW_CODE = 1, CW_READY = 32, CW_MODCNT = 64, CW_BAR = 4096;
constexpr unsigned CW_MAGIC = 0x600DF00Du;
constexpr int RING_OFF = 0, RING_BYTES = 131072;
constexpr int LDSCTL_OFF = 147456, MISC_OFF = LDSCTL_OFF + 320;
constexpr int LDS_BYTES = LDSCTL_OFF + 4096;
#define GAS __attribute__((address_space(1)))
#define LAS __attribute__((address_space(3)))
typedef unsigned short bf16;
typedef unsigned v4u __attribute__((ext_vector_type(4)));
typedef unsigned v2u __attribute__((ext_vector_type(2)));
typedef float f32x4 __attribute__((ext_vector_type(4)));
typedef short bf16x8 __attribute__((ext_vector_type(8)));
typedef GAS unsigned gu32;
#define RLX_AGENT __ATOMIC_RELAXED, __HIP_MEMORY_SCOPE_AGENT
#define LDS_WAIT() asm volatile("s_waitcnt lgkmcnt(0)" ::: "memory")
#define VM_WAIT() asm volatile("s_waitcnt vmcnt(0)" ::: "memory")
#define WG_BAR() do { asm volatile("s_waitcnt lgkmcnt(0)" ::: "memory"); __builtin_amdgcn_s_barrier(); asm volatile("" ::: "memory"); } while (0)
typedef __bf16 bf16n2 __attribute__((ext_vector_type(2)));
__device__ __forceinline__ unsigned f2bf(float f) { return (unsigned)__builtin_bit_cast(unsigned short, (__bf16)f); }
__device__ __forceinline__ unsigned pk2(float lo, float hi) { const bf16n2 v = {(__bf16)lo, (__bf16)hi}; return __builtin_bit_cast(unsigned, v); }
typedef short s16x4 __attribute__((ext_vector_type(4)));
__device__ __forceinline__ v2u lds_tr16(const LAS unsigned char* p) { return __builtin_bit_cast(v2u, __builtin_amdgcn_ds_read_tr16_b64_v4i16((LAS s16x4*)p)); }
__device__ __forceinline__ void st16_wt(void* base, unsigned nbytes, size_t byte_off, v4u v) {
    const __amdgpu_buffer_rsrc_t rs = __builtin_amdgcn_make_buffer_rsrc(base, 0, (int)nbytes, 0x00020000);
    __builtin_amdgcn_raw_buffer_store_b128(v, rs, (unsigned)byte_off, 0, 16);
}
__device__ __forceinline__ float bf2f(unsigned short u) { return __builtin_bit_cast(float, (unsigned)u << 16); }
__device__ __forceinline__ float bflo(unsigned w) { return __builtin_bit_cast(float, w << 16); }
__device__ __forceinline__ float bfhi(unsigned w) { return __builtin_bit_cast(float, w & 0xffff0000u); }
typedef unsigned u32x2_t __attribute__((ext_vector_type(2)));
template <int CTRL> __device__ __forceinline__ float dppf(float v) { return __builtin_bit_cast(float, __builtin_amdgcn_update_dpp(0, __builtin_bit_cast(int, v), CTRL, 0xF, 0xF, true)); }
template <int CTRL> __device__ __forceinline__ float dppf_old(float old, float v) { return __builtin_bit_cast(float, __builtin_amdgcn_update_dpp(__builtin_bit_cast(int, old), __builtin_bit_cast(int, v), CTRL, 0xF, 0xF, false)); }
constexpr int DPP_X1 = 0xB1, DPP_X2 = 0x4E, DPP_HMIR = 0x141, DPP_MIR = 0x140, DPP_ROR8 = 0x128;
__device__ __forceinline__ float sum_x16(float v) { const unsigned b = __builtin_bit_cast(unsigned, v); const u32x2_t r = __builtin_amdgcn_permlane16_swap(b, b, false, false); const unsigned a0 = r[0], a1 = r[1]; return __builtin_bit_cast(float, a0) + __builtin_bit_cast(float, a1); }
__device__ __forceinline__ float sum_x32(float v) { const unsigned b = __builtin_bit_cast(unsigned, v); const u32x2_t r = __builtin_amdgcn_permlane32_swap(b, b, false, false); const unsigned a0 = r[0], a1 = r[1]; return __builtin_bit_cast(float, a0) + __builtin_bit_cast(float, a1); }
__device__ __forceinline__ float max_x16(float v) { const unsigned b = __builtin_bit_cast(unsigned, v); const u32x2_t r = __builtin_amdgcn_permlane16_swap(b, b, false, false); const unsigned a0 = r[0], a1 = r[1]; return fmaxf(__builtin_bit_cast(float, a0), __builtin_bit_cast(float, a1)); }
__device__ __forceinline__ float max_x32(float v) { const unsigned b = __builtin_bit_cast(unsigned, v); const u32x2_t r = __builtin_amdgcn_permlane32_swap(b, b, false, false); const unsigned a0 = r[0], a1 = r[1]; return fmaxf(__builtin_bit_cast(float, a0), __builtin_bit_cast(float, a1)); }
__device__ __forceinline__ float shfl_x16(float v, int lane) { const unsigned b = __builtin_bit_cast(unsigned, v); const u32x2_t r = __builtin_amdgcn_permlane16_swap(b, b, false, false); const unsigned a0 = r[0], a1 = r[1]; return __builtin_bit_cast(float, (lane & 16) ? a0 : a1); }
__device__ __forceinline__ float shfl_x32(float v, int lane) { const unsigned b = __builtin_bit_cast(unsigned, v); const u32x2_t r = __builtin_amdgcn_permlane32_swap(b, b, false, false); const unsigned a0 = r[0], a1 = r[1]; return __builtin_bit_cast(float, (lane & 32) ? a0 : a1); }
__device__ __forceinline__ float grp8_sum(float v) { v += dppf<DPP_X1>(v); v += dppf<DPP_X2>(v); v += dppf<DPP_HMIR>(v); return v; }
__device__ __forceinline__ float grp16_sum(float v) { v = grp8_sum(v); v += dppf<DPP_MIR>(v); return v; }
__device__ __forceinline__ float wave_sum(float v) { v = grp16_sum(v); v = sum_x16(v); return sum_x32(v); }
__device__ __forceinline__ float lane_bcast(float v, int l) { return __builtin_bit_cast(float, __builtin_amdgcn_readlane(__builtin_bit_cast(int, v), l)); }
__device__ __forceinline__ float wave_scan_sum(float v, int lane) {
    v += dppf<0x111>(v); v += dppf<0x112>(v); v += dppf<0x114>(v); v += dppf<0x118>(v);
    const float s0 = lane_bcast(v, 15), s1 = lane_bcast(v, 31), s2 = lane_bcast(v, 47); const int row = lane >> 4;
    return v + (row == 0 ? 0.f : row == 1 ? s0 : row == 2 ? s0 + s1 : (s0 + s1) + s2);
}
__device__ __forceinline__ float wave_scan_max(float v, int lane) {
    const float ninf = -INFINITY;
    v = fmaxf(v, dppf_old<0x111>(ninf, v)); v = fmaxf(v, dppf_old<0x112>(ninf, v)); v = fmaxf(v, dppf_old<0x114>(ninf, v)); v = fmaxf(v, dppf_old<0x118>(ninf, v));
    const float s0 = lane_bcast(v, 15), s1 = lane_bcast(v, 31), s2 = lane_bcast(v, 47); const int row = lane >> 4;
    return fmaxf(v, row == 0 ? ninf : row == 1 ? s0 : row == 2 ? fmaxf(s0, s1) : fmaxf(fmaxf(s0, s1), s2));
}
__device__ __forceinline__ float silu(float x) { return x / (1.0f + __expf(-x)); }
__device__ __forceinline__ float sigmoidf_(float x) { return 1.0f / (1.0f + __expf(-x)); }
__device__ __forceinline__ float log_sigmoid(float z) { return fminf(z, 0.f) - log1pf(__expf(-fabsf(z))); }

#define XB_TMO      128
#define XB_XCNT(j)  (256  + 64 * (j))
#define XB_XSUB(j)  (1280 + 64 * (j))
#define XB_XGEN(j)  (2304 + 64 * (j))
#define XB_TOP      3328
#define XB_TOPGEN   3392
#define XCD_BAR_WORDS 3456
#define XB_SPIN_CAP (1u << 18)

__device__ __forceinline__ unsigned xb_ld(unsigned* p)              { return __hip_atomic_load(p, __ATOMIC_RELAXED, __HIP_MEMORY_SCOPE_AGENT); }
__device__ __forceinline__ unsigned xb_add(unsigned* p, unsigned v) { return __hip_atomic_fetch_add(p, v, __ATOMIC_RELAXED, __HIP_MEMORY_SCOPE_AGENT); }
__device__ __forceinline__ unsigned xb_xcc_id() { return (unsigned)__builtin_amdgcn_s_getreg((3 << 11) | 20) & 0xFu; }
#define XB_SPIN(cond, bar) do { unsigned _sp = 0; while (cond) { __builtin_amdgcn_s_sleep(1); \
    if ((++_sp & 255u) == 0u) { if (xb_ld(&(bar)[XB_TMO])) break; if (_sp > XB_SPIN_CAP) { atomicAdd(&(bar)[XB_TMO], 1u); break; } } } } while (0)

struct XcdBarrier {
    unsigned* bar; unsigned x;
    volatile LAS unsigned* st;
};

__device__ __forceinline__ XcdBarrier xcd_barrier_post(unsigned* bar, volatile LAS unsigned* st) {
    XcdBarrier b; b.bar = bar; b.x = xb_xcc_id(); b.st = st;
    if (threadIdx.x == 0) (void)xb_add(&bar[XB_XCNT(b.x)], 1u);
    return b;
}
__device__ __forceinline__ void xcd_barrier_complete(unsigned* bar, unsigned x, unsigned& nloc, unsigned& nx) {
    const unsigned G = gridDim.x * gridDim.y * gridDim.z;
    unsigned sum, cnt, mine, sp = 0u;
    for (;;) {
        sum = 0u; cnt = 0u; mine = 0u;
#pragma unroll
        for (unsigned j = 0; j < 16; ++j) { const unsigned c = xb_ld(&bar[XB_XCNT(j)]); sum += c; cnt += (c > 0u) ? 1u : 0u; mine = (j == x) ? c : mine; }
        if (sum == G) break;
        __builtin_amdgcn_s_sleep(1);
        if ((++sp & 255u) == 0u) { if (xb_ld(&bar[XB_TMO])) break; if (sp > XB_SPIN_CAP) { atomicAdd(&bar[XB_TMO], 1u); break; } }
    }
    nloc = mine > 0u ? mine : 1u; nx = cnt > 0u ? cnt : 1u;
}

template <int MODE = 0>
__device__ __forceinline__ void xcd_barrier(const XcdBarrier& b) {
    asm volatile("s_waitcnt vmcnt(0)" ::: "memory");
    __syncthreads();
    if (threadIdx.x < 64) {
        unsigned* bar = b.bar; const int lane = (int)threadIdx.x;
        unsigned gen = 0u;
        if (lane == 0) {
            __builtin_amdgcn_s_waitcnt(0);
            unsigned nloc = b.st[0], nx = b.st[1];
            if (nloc == 0u) { xcd_barrier_complete(bar, b.x, nloc, nx); unsigned mask = 0u;
#pragma unroll
                for (unsigned j = 0; j < 16; ++j) mask |= (xb_ld(&bar[XB_XCNT(j)]) > 0u ? 1u : 0u) << j;
                b.st[0] = nloc; b.st[1] = nx; b.st[2] = mask; }
            const unsigned old = xb_add(&bar[XB_XSUB(b.x)], 1u);
            gen = old / nloc;
            if (old + 1u == (gen + 1u) * nloc) {
                if (!(MODE & 1)) __builtin_amdgcn_fence(__ATOMIC_RELEASE, "agent");
                asm volatile("s_waitcnt vmcnt(0)" ::: "memory");
                xb_add(&bar[XB_XGEN(b.x)], 1u);
            }
        }
        gen = (unsigned)__builtin_amdgcn_readfirstlane((int)gen);
        const bool watch = lane < 16 && ((b.st[2] >> (lane & 15)) & 1u) != 0u;
        unsigned sp = 0u;
        for (;;) {
            const bool ok = !watch || xb_ld(&bar[XB_XGEN(lane & 15)]) > gen;
            if (__all(ok)) break;
            __builtin_amdgcn_s_sleep(4);
            if ((++sp & 255u) == 0u) { if (__builtin_amdgcn_readfirstlane((int)xb_ld(&bar[XB_TMO])) != 0) break; if (sp > XB_SPIN_CAP) { if (lane == 0) atomicAdd(&bar[XB_TMO], 1u); break; } }
        }
        if (!(MODE & 2)) __builtin_amdgcn_fence(__ATOMIC_ACQUIRE, "agent");
        asm volatile("s_waitcnt vmcnt(0)" ::: "memory");
    }
    __syncthreads();
}
struct Frame {
    LAS unsigned char* lds; volatile LAS unsigned* MISC; gu32* ctl;
    int tid, lane, wave, vcu, G;
    const float *x, *c, *g_mix, *w_in, *w_conv, *b_conv, *b_ig, *b_fg, *qn_g, *kn_g, *mn_g, *w_out, *g_ffn, *w_gate, *w_up, *w_down, *w_ada, *b_ada;
    float* out; unsigned char* ws;
};

template <int MODE>
__device__ __forceinline__ void p0_transpose_item(const float* W, int K, int ldw, int nblk, bf16* WT, unsigned wt_bytes, LAS float* scr, int item, int lane) {
    const int kb = item / nblk, nb = item % nblk, k0 = 64 * kb, n0 = 32 * nb;
    float tv[32];
#pragma unroll
    for (int i = 0; i < 32; ++i) tv[i] = __builtin_nontemporal_load(W + (size_t)(k0 + 2 * i + (lane >> 5)) * ldw + n0 + (lane & 31));
#pragma unroll
    for (int i = 0; i < 32; ++i) scr[(2 * i + (lane >> 5)) * 33 + (lane & 31)] = tv[i];
    LDS_WAIT(); asm volatile("" ::: "memory");
    const int c = lane & 7;
#pragma unroll
    for (int j = 0; j < 4; ++j) { const int n = (lane >> 3) + 8 * j; const LAS float* s = scr + (8 * c) * 33 + n;
        v4u o; o.x = pk2(s[0 * 33], s[1 * 33]); o.y = pk2(s[2 * 33], s[3 * 33]); o.z = pk2(s[4 * 33], s[5 * 33]); o.w = pk2(s[6 * 33], s[7 * 33]);
        int row = n0 + n; if (MODE) row = ((row >> 7) << 8) + (row & 127) + (MODE == 2 ? 128 : 0);
        st16_wt(WT, wt_bytes, ((size_t)row * K + k0 + 8 * c) * 2, o); }
    LDS_WAIT(); asm volatile("" ::: "memory");
}
__device__ __forceinline__ void p0_prologue(Frame& F) {
    {
        LAS float* red = (LAS float*)(F.lds + RING_OFF);
        float* mod = (float*)(F.ws + WS_MOD);
        for (int cg = blockIdx.x; cg < 256; cg += F.G) {
            const int n0 = 24 * cg;
            float acc[2][24];
#pragma unroll
            for (int i = 0; i < 24; ++i) { acc[0][i] = 0.f; acc[1][i] = 0.f; }
            for (int k = F.tid; k < D; k += NWAVES * 64) {
                const float s0 = silu(F.c[k]), s1 = silu(F.c[D + k]);
                const f32x4* wr = (const f32x4*)(F.w_ada + (size_t)k * NMOD + n0);
#pragma unroll
                for (int i = 0; i < 6; ++i) { const f32x4 w = __builtin_nontemporal_load(wr + i);
#pragma unroll
                    for (int e = 0; e < 4; ++e) { acc[0][4 * i + e] += s0 * w[e]; acc[1][4 * i + e] += s1 * w[e]; } }
            }
#pragma unroll
            for (int i = 0; i < 24; ++i) { acc[0][i] = wave_sum(acc[0][i]); acc[1][i] = wave_sum(acc[1][i]); }
            if (F.lane == 0) {
#pragma unroll
                for (int i = 0; i < 24; ++i) { red[F.wave * 48 + i] = acc[0][i]; red[F.wave * 48 + 24 + i] = acc[1][i]; } }
            __syncthreads();
            if (F.tid < 48) { float s = 0.f;
#pragma unroll
                for (int w = 0; w < NWAVES; ++w) s += red[w * 48 + F.tid];
                const int b = F.tid / 24, n = n0 + F.tid % 24; mod[b * NMOD + n] = s + F.b_ada[n]; }
            __syncthreads();
        }
    }
}
__device__ __forceinline__ void p0_mod_wide(Frame& F, int j) {
    LAS float* red = (LAS float*)(F.lds + RING_OFF);
    LAS float* scl = (LAS float*)(F.lds + RING_OFF + 32768);
    float* mod = (float*)(F.ws + WS_MOD);
    for (int i = F.tid; i < 2 * D; i += NWAVES * 64) scl[i] = silu(F.c[i]);
    __syncthreads();
    const int t = F.tid, q = t % 12, r = t / 12;
    if (t < 504) {
        f32x4 a0 = (f32x4){0.f, 0.f, 0.f, 0.f}, a1 = a0;
        const float* wp = F.w_ada + 48 * j + 4 * q;
#pragma unroll 5
        for (int k = r; k < D; k += 42) { const f32x4 w = __builtin_nontemporal_load((const f32x4*)(wp + (size_t)k * NMOD)); a0 += w * scl[k]; a1 += w * scl[D + k]; }
        *(LAS f32x4*)(red + (r * 12 + q) * 8) = a0; *(LAS f32x4*)(red + (r * 12 + q) * 8 + 4) = a1;
    }
    __syncthreads();
    if (t < 96) { const int b = t / 48, col = t % 48, qq = col >> 2, e = col & 3; float s = 0.f;
        for (int rr = 0; rr < 42; ++rr) s += red[(rr * 12 + qq) * 8 + b * 4 + e];
        mod[b * NMOD + 48 * j + col] = s + F.b_ada[48 * j + col]; }
    __syncthreads();
}
__device__ __forceinline__ void p0_win_copy(Frame& F, int wg0, int nwg) {
    LAS float* scr = (LAS float*)(F.lds + RING_OFF + F.wave * 16384);
    if ((int)blockIdx.x < wg0 || (int)blockIdx.x >= wg0 + nwg) return;
    const int gw = ((int)blockIdx.x - wg0) * NWAVES + F.wave, NGW = nwg * NWAVES;
    constexpr int I_IN = (D / 64) * (NIN / 32);
    bf16* Win_t = (bf16*)(F.ws + WS_WIN);
    for (int it = gw; it < I_IN; it += NGW) p0_transpose_item<0>(F.w_in, D, INC, NIN / 32, Win_t, (unsigned)(NIN * D * 2), scr, it, F.lane);
}
__device__ __forceinline__ void p0_late_weights(Frame& F, int first) {
    LAS float* scr = (LAS float*)(F.lds + RING_OFF + F.wave * 16384);
    const int nwg = F.G - first; if ((int)blockIdx.x < first || nwg <= 0) return;
    const int gw = ((int)blockIdx.x - first) * NWAVES + F.wave, NGW = nwg * NWAVES;
    constexpr int I_OUT = (D / 64) * (D / 32), I_G = (D / 64) * (FF / 32), I_DN = (FF / 64) * (D / 32);
    constexpr int NITEMS = I_OUT + 2 * I_G + I_DN;
    bf16* Wout_t = (bf16*)(F.ws + WS_WOUT); bf16* Wgu_t = (bf16*)(F.ws + WS_WGU); bf16* Wdn_t = (bf16*)(F.ws + WS_WDN);
    for (int it = gw; it < NITEMS; it += NGW) {
        int r = it;
        if (r < I_OUT) { p0_transpose_item<0>(F.w_out, D, D, D / 32, Wout_t, (unsigned)(D * D * 2), scr, r, F.lane); continue; } r -= I_OUT;
        if (r < I_G) { p0_transpose_item<1>(F.w_gate, D, FF, FF / 32, Wgu_t, (unsigned)(NGU * D * 2), scr, r, F.lane); continue; } r -= I_G;
        if (r < I_G) { p0_transpose_item<2>(F.w_up, D, FF, FF / 32, Wgu_t, (unsigned)(NGU * D * 2), scr, r, F.lane); continue; } r -= I_G;
        p0_transpose_item<0>(F.w_down, FF, D, D / 32, Wdn_t, (unsigned)(D * FF * 2), scr, r, F.lane);
    }
}
template <bool GATES, bool SRCB16 = false>
__device__ __forceinline__ void norm_rows(Frame& F, const float* src, const float* g, const float* mshift, const float* mscale, bf16* XN, float* gates) {
    LAS float* gwl = (LAS float*)(F.lds + RING_OFF);
    if (GATES) {
        for (int i = F.tid; i < 8 * D; i += NWAVES * 64) { const int k = i >> 3, j = i & 7; gwl[j * D + k] = F.w_in[(size_t)k * INC + NIN + j]; }
        __syncthreads();
    }
    const int gw = F.vcu * NWAVES + F.wave, NGW = F.G * NWAVES;
    f32x4 gs[4], sh[4]; int bcur = -1;
    for (int m = gw; m < M; m += 2 * NGW) {
        const int m2 = m + NGW; const bool has2 = m2 < M;
        f32x4 v[4], v2[4];
        if (SRCB16) {
            const GAS v2u* xr = (const GAS v2u*)((const bf16*)src + (size_t)m * D) + F.lane; const GAS v2u* xr2 = (const GAS v2u*)((const bf16*)src + (size_t)(has2 ? m2 : m) * D) + F.lane;
#pragma unroll
            for (int j = 0; j < 4; ++j) { const v2u a = xr[64 * j], b2 = xr2[64 * j]; v[j] = (f32x4){bflo(a.x), bfhi(a.x), bflo(a.y), bfhi(a.y)}; v2[j] = (f32x4){bflo(b2.x), bfhi(b2.x), bflo(b2.y), bfhi(b2.y)}; }
        } else {
            const GAS f32x4* xr = (const GAS f32x4*)(src + (size_t)m * D) + F.lane; const GAS f32x4* xr2 = (const GAS f32x4*)(src + (size_t)(has2 ? m2 : m) * D) + F.lane;
#pragma unroll
            for (int j = 0; j < 4; ++j) { v[j] = __builtin_nontemporal_load(xr + 64 * j); v2[j] = __builtin_nontemporal_load(xr2 + 64 * j); }
        }
#pragma unroll 1
        for (int half = 0; half < 2; ++half) {
            if (half == 1 && !has2) break;
            const int mm = half ? m2 : m; const int b = mm / SEQ;
            if (b != bcur) { bcur = b;
#pragma unroll
                for (int j = 0; j < 4; ++j) { const int k0 = 256 * j + 4 * F.lane; gs[j] = *(const f32x4*)(g + k0) * (*(const f32x4*)(mscale + (size_t)b * NMOD + k0) + 1.0f); sh[j] = *(const f32x4*)(mshift + (size_t)b * NMOD + k0); } }
            float ss = 0.f;
#pragma unroll
            for (int j = 0; j < 4; ++j) { if (half) v[j] = v2[j]; ss += (v[j].x * v[j].x + v[j].y * v[j].y) + (v[j].z * v[j].z + v[j].w * v[j].w); }
            const float rstd = 1.0f / sqrtf(wave_sum(ss) * (1.f / D) + RMS_EPS);
            float ga[8];
#pragma unroll
            for (int c = 0; c < 8; ++c) ga[c] = 0.f;
            GAS unsigned long long* o8 = (GAS unsigned long long*)(XN + (size_t)mm * D) + F.lane;
#pragma unroll
            for (int j = 0; j < 4; ++j) {
                const int k0 = 256 * j + 4 * F.lane;
                const f32x4 h = (v[j] * rstd) * gs[j] + sh[j];
                o8[64 * j] = (unsigned long long)pk2(h.x, h.y) | ((unsigned long long)pk2(h.z, h.w) << 32);
                if (GATES) {
#pragma unroll
                    for (int c = 0; c < 8; ++c) { const f32x4 w4 = *(const LAS f32x4*)(gwl + c * D + k0); ga[c] += (h.x * w4.x + h.y * w4.y) + (h.z * w4.z + h.w * w4.w); }
                }
            }
            if (GATES) {
                const bool up = F.lane & 32, b4 = F.lane & 16, b3 = F.lane & 8;
                float k4[4], k2[2];
#pragma unroll
                for (int i = 0; i < 4; ++i) { const float snd = up ? ga[i] : ga[4 + i]; k4[i] = (up ? ga[4 + i] : ga[i]) + shfl_x32(snd, F.lane); }
#pragma unroll
                for (int i = 0; i < 2; ++i) { const float snd = b4 ? k4[i] : k4[2 + i]; k2[i] = (b4 ? k4[2 + i] : k4[i]) + shfl_x16(snd, F.lane); }
                float gv = (b3 ? k2[1] : k2[0]) + dppf<DPP_ROR8>(b3 ? k2[0] : k2[1]);
                gv = grp8_sum(gv);
                if ((F.lane & 7) == 0) { const int c = 4 * (F.lane >> 5) + 2 * ((F.lane >> 4) & 1) + ((F.lane >> 3) & 1);
                    gates[(size_t)mm * 8 + c] = c < 4 ? gv + F.b_ig[c] : log_sigmoid(gv + F.b_fg[c - 4]); }
            }
        }
    }
}
namespace pg8 {
struct EpiResToB16 {
    static constexpr bool PERM = true, AFTER_DRAIN = false;
    const float* base; bf16_t* out; int ldc; const float* gate; int gate_stride; int rows_per_batch; size_t out_bytes;
    __device__ __forceinline__ void operator()(const f32x4 (&acc)[2][2][4][2], const Unit& u, int wr, int wc, int fr, int fq) const {
        const int col0 = u.pn * BM + wc * 32 + 8 * fq; const int b = (u.pm * BM) / rows_per_batch;
        f32x4 gv[2][2];
#pragma unroll
        for (int bj = 0; bj < 2; ++bj)
#pragma unroll
            for (int n = 0; n < 2; ++n) gv[bj][n] = *(const f32x4*)(gate + (size_t)b * gate_stride + col0 + bj * HALF + n * 4);
#pragma unroll
        for (int ai = 0; ai < 2; ++ai)
#pragma unroll
            for (int m = 0; m < 4; ++m) { const size_t off = (size_t)(u.pm * BM + ai * HALF + wr * 64 + m * 16 + fr) * ldc + col0;
#pragma unroll
                for (int bj = 0; bj < 2; ++bj) { const f32x4 b0 = __builtin_nontemporal_load((const f32x4*)(base + off + bj * HALF)), b1 = __builtin_nontemporal_load((const f32x4*)(base + off + bj * HALF + 4));
                    const f32x4 o0 = b0 + gv[bj][0] * acc[ai][bj][m][0], o1 = b1 + gv[bj][1] * acc[ai][bj][m][1];
                    u32x4 w; w.x = cvt_pk_bf16(o0[0], o0[1]); w.y = cvt_pk_bf16(o0[2], o0[3]); w.z = cvt_pk_bf16(o1[0], o1[1]); w.w = cvt_pk_bf16(o1[2], o1[3]);
                    st16_wt(out, (unsigned)out_bytes, (off + bj * HALF) * 2, __builtin_bit_cast(v4u, w)); } }
    }
};
struct EpiResFromB16 {
    static constexpr bool PERM = true, AFTER_DRAIN = false;
    const bf16_t* base; float* out; int ldc; const float* gate; int gate_stride; int rows_per_batch;
    __device__ __forceinline__ void operator()(const f32x4 (&acc)[2][2][4][2], const Unit& u, int wr, int wc, int fr, int fq) const {
        const int col0 = u.pn * BM + wc * 32 + 8 * fq; const int b = (u.pm * BM) / rows_per_batch;
        f32x4 gv[2][2];
#pragma unroll
        for (int bj = 0; bj < 2; ++bj)
#pragma unroll
            for (int n = 0; n < 2; ++n) gv[bj][n] = *(const f32x4*)(gate + (size_t)b * gate_stride + col0 + bj * HALF + n * 4);
#pragma unroll
        for (int ai = 0; ai < 2; ++ai)
#pragma unroll
            for (int m = 0; m < 4; ++m) { const size_t off = (size_t)(u.pm * BM + ai * HALF + wr * 64 + m * 16 + fr) * ldc + col0;
#pragma unroll
                for (int bj = 0; bj < 2; ++bj) { const u32x4 bw = __builtin_nontemporal_load((const u32x4*)(base + off + bj * HALF));
                    const f32x4 b0 = (f32x4){bflo(bw.x), bfhi(bw.x), bflo(bw.y), bfhi(bw.y)}, b1 = (f32x4){bflo(bw.z), bfhi(bw.z), bflo(bw.w), bfhi(bw.w)};
                    __builtin_nontemporal_store(b0 + gv[bj][0] * acc[ai][bj][m][0], (f32x4*)(out + off + bj * HALF)); __builtin_nontemporal_store(b1 + gv[bj][1] * acc[ai][bj][m][1], (f32x4*)(out + off + bj * HALF + 4)); } }
    }
};
}
constexpr int AT_KROWS = 256, AT_KSTR = 144  , AT_VSTR = 144  ;
constexpr int AT_VT_OFF = AT_KROWS * AT_KSTR, AT_BUF = AT_VT_OFF + AT_KROWS * AT_VSTR;
constexpr int AT_RK_OFF = LDSCTL_OFF + 1024;
static_assert(2 * AT_BUF <= LDSCTL_OFF && AT_RK_OFF + 2 * AT_KROWS * 4 <= LDS_BYTES, "attention LDS double buffer");
constexpr int AT_UNITS = 3 * 16 * 64;
struct AtUnit { int p, b, h, r, rho, i0; };
__device__ __forceinline__ AtUnit at_decode(int u) { AtUnit U; U.p = u >> 10; const int bh = (u >> 6) & 15, cb = u & 63; U.b = bh >> 3; U.h = bh & 7;
    const int sh = 2 * U.p; U.r = 1 << sh; const int nbc = 64 >> sh; U.rho = cb / nbc; U.i0 = 128 * (cb % nbc); return U; }
__device__ __forceinline__ void at_prefetch(const Frame& F, const bf16* XIN, int u, v4u (&pk)[4], v4u (&pv)[4], v4u (&pq)[2]) {
    const AtUnit U = at_decode(u); const int w = F.wave, fr = F.lane & 15, g = F.lane >> 4;
    const int kr0 = F.tid >> 3, c = F.tid & 7;
    const bf16* row0 = XIN + ((long)U.b * SEQ + (long)(U.i0 - 128 + kr0) * U.r + U.rho) * NIN + U.h * 64 + 8 * c;
    const long step = (long)64 * U.r * NIN;
#pragma unroll
    for (int it = 0; it < 4; ++it) { pk[it] = (v4u){0u, 0u, 0u, 0u}; pv[it] = (v4u){0u, 0u, 0u, 0u};
        if (U.i0 - 128 + kr0 + 64 * it >= 0) { pk[it] = *(const v4u*)(row0 + it * step + C_KA); pv[it] = *(const v4u*)(row0 + it * step + C_VA); } }
    const bf16* qrow = XIN + ((size_t)U.b * SEQ + (size_t)(U.i0 + 16 * w + fr) * U.r + U.rho) * NIN + C_QA + U.h * 64 + 8 * g;
    pq[0] = *(const v4u*)qrow; pq[1] = *(const v4u*)(qrow + 32);
}
struct AtCarry { bf16x8 qf[2]; };
template <bool CMB>
__device__ __forceinline__ void at_stage(const Frame& F, const bf16* OP, const float* LSE, int u, int buf, const v4u (&pk)[4], const v4u (&pv)[4], const v4u (&pq)[2], const float (&gqk)[16], AtCarry& C) {
    LAS unsigned char* KL = F.lds + RING_OFF + buf * AT_BUF; LAS unsigned char* VL = KL + AT_VT_OFF; LAS float* RK = (LAS float*)(F.lds + AT_RK_OFF) + buf * AT_KROWS;
    const int lane = F.lane, w = F.wave, fr = lane & 15, g = lane >> 4;
    const AtUnit U = at_decode(u);
#pragma unroll
    for (int it = 0; it < 4; ++it) { const int kr = (F.tid >> 3) + 64 * it, c = F.tid & 7;
        const v4u kv = pk[it];
        float ss = 0.f;
#pragma unroll
        for (int e = 0; e < 4; ++e) { const unsigned ke = kv[e]; const bf16n2 k2 = __builtin_bit_cast(bf16n2, ke);     ss = __builtin_amdgcn_fdot2_f32_bf16(k2, k2, ss, false); }
        ss = grp8_sum(ss);
        *(LAS v4u*)(KL + kr * AT_KSTR + c * 16) = kv;
        *(LAS v4u*)(VL + kr * AT_VSTR + c * 16) = pv[it];
        if (c == 0) RK[kr] = __builtin_amdgcn_rsqf(ss * (1.f / 64) + RMS_EPS); }
    {
        float qv[16]; float ss = 0.f;
#pragma unroll
        for (int ks = 0; ks < 2; ++ks)
#pragma unroll
            for (int e = 0; e < 4; ++e) { qv[8 * ks + 2 * e] = bflo(pq[ks][e]); qv[8 * ks + 2 * e + 1] = bfhi(pq[ks][e]); }
#pragma unroll
        for (int i = 0; i < 16; ++i) ss += qv[i] * qv[i];
        ss = sum_x32(sum_x16(ss));
        const float rq = (0.125f * 1.44269504089f) * __builtin_amdgcn_rsqf(ss * (1.f / 64) + RMS_EPS);
#pragma unroll
        for (int ks = 0; ks < 2; ++ks) { v4u o;
#pragma unroll
            for (int e = 0; e < 4; ++e) o[e] = pk2(qv[8 * ks + 2 * e] * rq * gqk[8 * ks + 2 * e], qv[8 * ks + 2 * e + 1] * rq * gqk[8 * ks + 2 * e + 1]);
            C.qf[ks] = __builtin_bit_cast(bf16x8, o); }
    }
}
template <bool CMB>
__device__ __forceinline__ void at_compute(const Frame& F, bf16* OP, float* LSE, bf16* CAT, int u, int buf, const AtCarry& C) {
    const LAS unsigned char* KL = F.lds + RING_OFF + buf * AT_BUF; const LAS unsigned char* VL = KL + AT_VT_OFF; const LAS float* RK = (const LAS float*)(F.lds + AT_RK_OFF) + buf * AT_KROWS;
    const int lane = F.lane, w = F.wave, fr = lane & 15, g = lane >> 4;
    const AtUnit U = at_decode(u);
    const size_t mq = (size_t)U.b * SEQ + (size_t)(U.i0 + 16 * w + fr) * U.r + U.rho;
    v2u co[2][4]; float cl[2];
    if (CMB) {
#pragma unroll
        for (int q = 0; q < 2; ++q) { cl[q] = LSE[((size_t)(q + 1) * M + mq) * 8 + U.h];
#pragma unroll
            for (int dt = 0; dt < 4; ++dt) co[q][dt] = *(const v2u*)(OP + ((size_t)(q + 1) * M + mq) * 512 + U.h * 64 + 16 * dt + 4 * g); } }
    f32x4 sacc[9];
#pragma unroll
    for (int kt = 0; kt < 9; ++kt) { sacc[kt] = (f32x4){0.f, 0.f, 0.f, 0.f};
#pragma unroll
        for (int ks = 0; ks < 2; ++ks) { const bf16x8 a = *(const LAS bf16x8*)(KL + (16 * w + 16 * kt + fr) * AT_KSTR + (32 * ks + 8 * g) * 2);
            sacc[kt] = __builtin_amdgcn_mfma_f32_16x16x32_bf16(a, C.qf[ks], sacc[kt], 0, 0, 0); }
        sacc[kt] = sacc[kt] * *(const LAS f32x4*)(RK + 16 * w + 16 * kt + 4 * g); }
#pragma unroll
    for (int rr = 0; rr < 4; ++rr) { if (fr > 4 * g + rr) sacc[0][rr] = -INFINITY; if (fr < 4 * g + rr) sacc[8][rr] = -INFINITY; }
    if (U.i0 == 0) {
#pragma unroll
        for (int kt = 0; kt < 9; ++kt)
#pragma unroll
            for (int rr = 0; rr < 4; ++rr) if (16 * w + 16 * kt + 4 * g + rr < 128) sacc[kt][rr] = -INFINITY;
    }
    float mx = -INFINITY;
#pragma unroll
    for (int kt = 0; kt < 9; ++kt) mx = fmaxf(mx, fmaxf(fmaxf(sacc[kt][0], sacc[kt][1]), fmaxf(sacc[kt][2], sacc[kt][3])));
    mx = max_x32(max_x16(mx));
    float lsum = 0.f;
#pragma unroll
    for (int kt = 0; kt < 9; ++kt)
#pragma unroll
        for (int rr = 0; rr < 4; ++rr) { const float pv_ = __builtin_amdgcn_exp2f(sacc[kt][rr] - mx); sacc[kt][rr] = pv_; lsum += pv_; }
    lsum = sum_x32(sum_x16(lsum));
    f32x4 oacc[4];
#pragma unroll
    for (int dt = 0; dt < 4; ++dt) oacc[dt] = (f32x4){0.f, 0.f, 0.f, 0.f};
    const LAS unsigned char* vbase = VL + (16 * w + 4 * g + (fr >> 2)) * AT_VSTR + (fr & 3) * 8;
#pragma unroll
    for (int pp = 0; pp < 5; ++pp) {
        v4u pb; pb.x = pk2(sacc[2 * pp][0], sacc[2 * pp][1]); pb.y = pk2(sacc[2 * pp][2], sacc[2 * pp][3]);
        if (pp < 4) { pb.z = pk2(sacc[2 * pp + 1][0], sacc[2 * pp + 1][1]); pb.w = pk2(sacc[2 * pp + 1][2], sacc[2 * pp + 1][3]); } else { pb.z = 0u; pb.w = 0u; }
        const bf16x8 bfrag = __builtin_bit_cast(bf16x8, pb);
#pragma unroll
        for (int dt = 0; dt < 4; ++dt) { const LAS unsigned char* vr = vbase + (32 * pp) * AT_VSTR + 32 * dt;
            const v2u lo = lds_tr16(vr); v2u hi = (v2u){0u, 0u}; if (pp < 4) hi = lds_tr16(vr + 16 * AT_VSTR);
            const v4u av = (v4u){lo.x, lo.y, hi.x, hi.y};
            oacc[dt] = __builtin_amdgcn_mfma_f32_16x16x32_bf16(__builtin_bit_cast(bf16x8, av), bfrag, oacc[dt], 0, 0, 0); }
    }
    const float inv = __builtin_amdgcn_rcpf(lsum);
    const float lse0 = (mx + __log2f(lsum)) * 0.69314718056f;
    if (CMB) {
        const float mm = fmaxf(lse0, fmaxf(cl[0], cl[1])); float e0 = __expf(lse0 - mm), e1 = __expf(cl[0] - mm), e2 = __expf(cl[1] - mm);
        const float is = __builtin_amdgcn_rcpf(e0 + e1 + e2); e0 *= is * inv; e1 *= is; e2 *= is;
        bf16* crow = CAT + mq * 1024 + U.h * 64 + 4 * g;
#pragma unroll
        for (int dt = 0; dt < 4; ++dt) { v2u o;
            o.x = pk2(e0 * oacc[dt][0] + e1 * bflo(co[0][dt].x) + e2 * bflo(co[1][dt].x), e0 * oacc[dt][1] + e1 * bfhi(co[0][dt].x) + e2 * bfhi(co[1][dt].x));
            o.y = pk2(e0 * oacc[dt][2] + e1 * bflo(co[0][dt].y) + e2 * bflo(co[1][dt].y), e0 * oacc[dt][3] + e1 * bfhi(co[0][dt].y) + e2 * bfhi(co[1][dt].y));
            *(v2u*)(crow + 16 * dt) = o; }
    } else {
        bf16* orow = OP + ((size_t)U.p * M + mq) * 512 + U.h * 64 + 4 * g;
#pragma unroll
        for (int dt = 0; dt < 4; ++dt) { v2u o; o.x = pk2(oacc[dt][0] * inv, oacc[dt][1] * inv); o.y = pk2(oacc[dt][2] * inv, oacc[dt][3] * inv); *(v2u*)(orow + 16 * dt) = o; }
        if (g == 0) LSE[((size_t)U.p * M + mq) * 8 + U.h] = lse0;
    }
}
template <bool CMB>
__device__ __forceinline__ void attn_phase(Frame& F, const bf16* XIN, bf16* OP, float* LSE, bf16* CAT, int ubeg, int uend) {
    const int g = F.lane >> 4;
    float gqk[16];
#pragma unroll
    for (int ks = 0; ks < 2; ++ks)
#pragma unroll
        for (int i = 0; i < 8; ++i) { const int d = 32 * ks + 8 * g + i; gqk[8 * ks + i] = F.qn_g[d] * F.kn_g[d]; }
    const int per = (uend - ubeg + F.G - 1) / F.G; const int u0 = ubeg + F.vcu * per; const int u1 = (u0 + per < uend) ? u0 + per : uend; const int n = u1 - u0;
    if (n <= 0) return;
    v4u pkA[4], pvA[4], pqA[2], pkB[4], pvB[4], pqB[2]; AtCarry cur, nxt;
    at_prefetch(F, XIN, u0, pkA, pvA, pqA);
    if (n > 1) at_prefetch(F, XIN, u0 + 1, pkB, pvB, pqB);
    at_stage<CMB>(F, OP, LSE, u0, 0, pkA, pvA, pqA, gqk, cur);
    if (n > 2) at_prefetch(F, XIN, u0 + 2, pkA, pvA, pqA);
    WG_BAR();
    for (int i = 0; i < n; i += 2) {
        if (i + 1 < n) { at_stage<CMB>(F, OP, LSE, u0 + i + 1, 1, pkB, pvB, pqB, gqk, nxt); if (i + 3 < n) at_prefetch(F, XIN, u0 + i + 3, pkB, pvB, pqB); }
        at_compute<CMB>(F, OP, LSE, CAT, u0 + i, 0, cur);
        WG_BAR();
        if (i + 1 < n) {
            if (i + 2 < n) { at_stage<CMB>(F, OP, LSE, u0 + i + 2, 0, pkA, pvA, pqA, gqk, cur); if (i + 4 < n) at_prefetch(F, XIN, u0 + i + 4, pkA, pvA, pqA); }
            at_compute<CMB>(F, OP, LSE, CAT, u0 + i + 1, 1, nxt);
            WG_BAR();
        }
    }
}
constexpr int ML_G = 32, ML_NC = 4, ML_UNITS = 8 * ML_G;
static_assert(ML_G * ML_NC * 64 == SEQ, "mLSTM grouping");
constexpr int ML_RS = 288;
constexpr int ML_QN = 0, ML_KN = 18432, ML_KWN = 36864, ML_VN = 55296, ML_SD = 73728, ML_F = 82944, ML_CW = 87552, ML_RAWQ = 92672, ML_RAWK = 110896;
constexpr int ML_RAWS = 272;
static_assert(ML_RAWK + 67 * ML_RAWS <= RING_BYTES, "mLSTM LDS map");
constexpr int MF_U = 0, MF_M = 64, MF_B = 128, MF_RS = 192, MF_QN = 448, MF_NV = 512, MF_HSS = 640;
constexpr float K_SCALE = 0.08838834764831845f;
__device__ __forceinline__ void conv8_lds(const LAS unsigned char* raw, const LAS float* cw, int s, int c, float (&y)[8]) {
    const f32x4 b0 = *(const LAS f32x4*)(cw + 4 * 128 + 8 * c), b1 = *(const LAS f32x4*)(cw + 4 * 128 + 8 * c + 4);
    y[0] = b0[0]; y[1] = b0[1]; y[2] = b0[2]; y[3] = b0[3]; y[4] = b1[0]; y[5] = b1[1]; y[6] = b1[2]; y[7] = b1[3];
#pragma unroll
    for (int j = 0; j < 4; ++j) { const v4u x = *(const LAS v4u*)(raw + (s + j) * ML_RAWS + c * 16);
        const f32x4 w0 = *(const LAS f32x4*)(cw + j * 128 + 8 * c), w1 = *(const LAS f32x4*)(cw + j * 128 + 8 * c + 4);
        y[0] += w0[0] * bflo(x[0]); y[1] += w0[1] * bfhi(x[0]); y[2] += w0[2] * bflo(x[1]); y[3] += w0[3] * bfhi(x[1]);
        y[4] += w1[0] * bflo(x[2]); y[5] += w1[1] * bfhi(x[2]); y[6] += w1[2] * bflo(x[3]); y[7] += w1[3] * bfhi(x[3]); }
#pragma unroll
    for (int i = 0; i < 8; ++i) y[i] = y[i] * __builtin_amdgcn_rcpf(1.0f + __builtin_amdgcn_exp2f(-1.44269504089f * y[i]));
}
constexpr int M2_HT = 87552, M2_HTS = 528;
constexpr int MF_INT = 192, MF_EMT = 256;
static_assert(M2_HT + 64 * M2_HTS <= RING_BYTES, "pass-2 LDS map");
__device__ __forceinline__ void mlstm_pass2(Frame& F, const bf16* XIN, const bf16* QKc, const float* gates, bf16* CAT) {
    LAS unsigned char* L = F.lds + RING_OFF; LAS float* LF = (LAS float*)(L + ML_F);
    float* STC = (float*)(F.ws + WS_STC); float* STN = (float*)(F.ws + WS_STN); float* STS = (float*)(F.ws + WS_STS);
    const int lane0 = F.lane, w = F.wave, tid0 = F.tid;
#define ML_OPAQUE() int lane = lane0, tid = tid0; asm volatile("" : "+v"(lane), "+v"(tid)); const int fr = lane & 15, g = lane >> 4; (void)fr; (void)g; (void)tid
    v4u rq[2], rk[2], rv[2], ro[2]; float glf, gli;
#define M2_PREFETCH(unit_, ck_) do { const int bh_ = (unit_) / ML_G, grp_ = (unit_) % ML_G; const int b_ = bh_ >> 2, hh_ = bh_ & 3; const int t0_ = (grp_ * ML_NC + (ck_)) * 64; \
        ML_OPAQUE(); \
        _Pragma("unroll") for (int j = 0; j < 2; ++j) { const int item = tid + NWAVES * 64 * j; const size_t mr = (size_t)b_ * SEQ + t0_ + (item >> 4); const int c = item & 15; \
            rq[j] = *(const v4u*)(QKc + mr * 1024 + hh_ * 128 + 8 * c); rk[j] = *(const v4u*)(QKc + mr * 1024 + 512 + hh_ * 128 + 8 * c); \
            rv[j] = *(const v4u*)(XIN + mr * NIN + C_VM + hh_ * 128 + 8 * c); ro[j] = *(const v4u*)(XIN + mr * NIN + C_OG + hh_ * 128 + 8 * c); } \
        glf = gates[((size_t)b_ * SEQ + t0_ + lane) * 8 + 4 + hh_]; gli = gates[((size_t)b_ * SEQ + t0_ + lane) * 8 + hh_]; } while (0)
    if (F.vcu < ML_UNITS) M2_PREFETCH(F.vcu, 0);
    for (int unit = F.vcu; unit < ML_UNITS; unit += F.G) {
        const int bh = unit / ML_G, grp = unit % ML_G; const int b = bh >> 2, hh = bh & 3;
        f32x4 accC[8], accN; float mrun; f32x4 gn[2];
        { ML_OPAQUE();
#pragma unroll
          for (int dt = 0; dt < 8; ++dt) accC[dt] = *(const f32x4*)(STC + (size_t)unit * 16384 + ((w * 8 + dt) * 64 + lane) * 4);
          accN = *(const f32x4*)(STN + unit * 128 + 16 * w + 4 * g);
          mrun = STS[unit * 4 + 2]; if (fr == 0) *(LAS f32x4*)(LF + MF_NV + 16 * w + 4 * g) = accN;
          gn[0] = *(const f32x4*)(F.mn_g + hh * 128 + 8 * (tid & 15)); gn[1] = *(const f32x4*)(F.mn_g + hh * 128 + 8 * (tid & 15) + 4); }
#pragma unroll 1
        for (int ck = 0; ck < ML_NC; ++ck) {
            const int t0 = (grp * ML_NC + ck) * 64; const size_t m0 = (size_t)b * SEQ + t0;
            float blast, Mlast, decay; v4u og2[2];
            { ML_OPAQUE();
            const float lf = glf, li = gli;
            const float bc = wave_scan_sum(lf, lane);
            const float u = li - bc;
            const float pm = wave_scan_max(u, lane);
            const float Mt = fmaxf(mrun, pm);
            blast = lane_bcast(bc, 63); Mlast = lane_bcast(Mt, 63);
            const float wv = __expf(u - Mlast); decay = __expf(mrun - Mlast);
            if (w == 0) { LF[MF_U + lane] = u; LF[MF_M + lane] = Mt; LF[MF_INT + lane] = __expf(mrun - Mt); LF[MF_EMT + lane] = __expf(-(bc + Mt)); }
#pragma unroll
            for (int j = 0; j < 2; ++j) { const int item = tid + NWAVES * 64 * j; const int s = item >> 4, c = item & 15;
                const float wsc = __shfl(wv, s);
                *(LAS v4u*)(L + ML_QN + s * ML_RS + c * 16) = rq[j]; *(LAS v4u*)(L + ML_KN + s * ML_RS + c * 16) = rk[j]; *(LAS v4u*)(L + ML_VN + s * ML_RS + c * 16) = rv[j];
                v4u ow;
#pragma unroll
                for (int e = 0; e < 4; ++e) ow[e] = pk2(bflo(rk[j][e]) * wsc, bfhi(rk[j][e]) * wsc);
                *(LAS v4u*)(L + ML_KWN + s * ML_RS + c * 16) = ow; og2[j] = ro[j]; }
            }
            if (ck + 1 < ML_NC) M2_PREFETCH(unit, ck + 1); else if (unit + F.G < ML_UNITS) M2_PREFETCH(unit + F.G, 0);
            WG_BAR();
            bf16x8 vfrag[2];
            { ML_OPAQUE();
#pragma unroll
            for (int ks = 0; ks < 2; ++ks) { const LAS unsigned char* vp = L + ML_VN + (32 * ks + 8 * g + (fr >> 2)) * ML_RS + (16 * w + 4 * (fr & 3)) * 2;
                const v2u lo = lds_tr16(vp), hi = lds_tr16(vp + 4 * ML_RS); vfrag[ks] = __builtin_bit_cast(bf16x8, (v4u){lo.x, lo.y, hi.x, hi.y}); } }
            { ML_OPAQUE(); const int ti = w >> 1; const int t = 16 * ti + fr; const float Mt_t = LF[MF_M + t];
#pragma unroll
              for (int q = 0; q < 2; ++q) { const int si = 2 * (w & 1) + q; f32x4 acc = (f32x4){0.f, 0.f, 0.f, 0.f};
#pragma unroll
                for (int ks = 0; ks < 4; ++ks) { const bf16x8 a = *(const LAS bf16x8*)(L + ML_KN + (16 * si + fr) * ML_RS + (32 * ks + 8 * g) * 2);
                    const bf16x8 bq = *(const LAS bf16x8*)(L + ML_QN + (16 * ti + fr) * ML_RS + (32 * ks + 8 * g) * 2);
                    acc = __builtin_amdgcn_mfma_f32_16x16x32_bf16(a, bq, acc, 0, 0, 0); }
                const f32x4 us = *(const LAS f32x4*)(LF + MF_U + 16 * si + 4 * g); float sd[4];
#pragma unroll
                for (int rr = 0; rr < 4; ++rr) { const int s = 16 * si + 4 * g + rr; sd[rr] = (s <= t) ? acc[rr] * __expf(us[rr] - Mt_t) : 0.f; }
                v2u o; o.x = pk2(sd[0], sd[1]); o.y = pk2(sd[2], sd[3]);
                *(LAS v2u*)(L + ML_SD + t * 144 + (16 * si + 4 * g) * 2) = o; } }
            WG_BAR();
            { ML_OPAQUE();
            f32x4 hacc[4], qacc[4], racc[4];
#pragma unroll
            for (int ti = 0; ti < 4; ++ti) { hacc[ti] = (f32x4){0.f, 0.f, 0.f, 0.f}; qacc[ti] = (f32x4){0.f, 0.f, 0.f, 0.f}; racc[ti] = (f32x4){0.f, 0.f, 0.f, 0.f}; }
            bf16x8 qfr[4][4]; f32x4 nv0[4], nv1[4];
#pragma unroll
            for (int ks = 0; ks < 4; ++ks) { nv0[ks] = *(const LAS f32x4*)(LF + MF_NV + 32 * ks + 4 * g); nv1[ks] = *(const LAS f32x4*)(LF + MF_NV + 32 * ks + 16 + 4 * g);
#pragma unroll
                for (int ti = 0; ti < 4; ++ti) { const LAS unsigned char* qp = L + ML_QN + (16 * ti + fr) * ML_RS + (32 * ks + 4 * g) * 2;
                    const v2u lo = *(const LAS v2u*)qp, hi = *(const LAS v2u*)(qp + 32); qfr[ks][ti] = __builtin_bit_cast(bf16x8, (v4u){lo.x, lo.y, hi.x, hi.y}); } }
#pragma unroll
            for (int ks = 0; ks < 4; ++ks) {
                v4u cb; cb.x = pk2(accC[2 * ks][0], accC[2 * ks][1]); cb.y = pk2(accC[2 * ks][2], accC[2 * ks][3]); cb.z = pk2(accC[2 * ks + 1][0], accC[2 * ks + 1][1]); cb.w = pk2(accC[2 * ks + 1][2], accC[2 * ks + 1][3]);
                const bf16x8 cfrag = __builtin_bit_cast(bf16x8, cb);
                v4u nb; nb.x = pk2(nv0[ks][0], nv0[ks][1]); nb.y = pk2(nv0[ks][2], nv0[ks][3]); nb.z = pk2(nv1[ks][0], nv1[ks][1]); nb.w = pk2(nv1[ks][2], nv1[ks][3]);
                const bf16x8 nfrag = __builtin_bit_cast(bf16x8, nb);
#pragma unroll
                for (int ti = 0; ti < 4; ++ti) {
                    hacc[ti] = __builtin_amdgcn_mfma_f32_16x16x32_bf16(qfr[ks][ti], cfrag, hacc[ti], 0, 0, 0);
                    qacc[ti] = __builtin_amdgcn_mfma_f32_16x16x32_bf16(qfr[ks][ti], nfrag, qacc[ti], 0, 0, 0); }
            }
            f32x4 inter[4];
#pragma unroll
            for (int ti = 0; ti < 4; ++ti) { inter[ti] = *(const LAS f32x4*)(LF + MF_INT + 16 * ti + 4 * g); hacc[ti] = hacc[ti] * inter[ti]; }
            const bf16x8 ones = __builtin_bit_cast(bf16x8, (v4u){0x3f803f80u, 0x3f803f80u, 0x3f803f80u, 0x3f803f80u});
            bf16x8 sdf[2][4];
#pragma unroll
            for (int ks = 0; ks < 2; ++ks)
#pragma unroll
                for (int ti = 0; ti < 4; ++ti) sdf[ks][ti] = *(const LAS bf16x8*)(L + ML_SD + (16 * ti + fr) * 144 + (32 * ks + 8 * g) * 2);
#pragma unroll
            for (int ks = 0; ks < 2; ++ks)
#pragma unroll
                for (int ti = 0; ti < 4; ++ti) {
                    hacc[ti] = __builtin_amdgcn_mfma_f32_16x16x32_bf16(sdf[ks][ti], vfrag[ks], hacc[ti], 0, 0, 0);
                    racc[ti] = __builtin_amdgcn_mfma_f32_16x16x32_bf16(sdf[ks][ti], ones, racc[ti], 0, 0, 0); }
#pragma unroll
            for (int ti = 0; ti < 4; ++ti) { const f32x4 emt = *(const LAS f32x4*)(LF + MF_EMT + 16 * ti + 4 * g);
#pragma unroll
                for (int rr = 0; rr < 4; ++rr) { const float den = fmaxf(fabsf(inter[ti][rr] * qacc[ti][rr] + racc[ti][rr]), emt[rr]);
                    *(LAS float*)(L + M2_HT + (16 * ti + 4 * g + rr) * M2_HTS + (16 * w + fr) * 4) = hacc[ti][rr] * __builtin_amdgcn_rcpf(den); } }
            const LAS unsigned char* kp = L + ML_KWN + (8 * g + (fr >> 2)) * ML_RS + 4 * (fr & 3) * 2;
#pragma unroll
            for (int dt = 0; dt < 8; ++dt) accC[dt] = accC[dt] * decay;
            accN = accN * decay;
#pragma unroll
            for (int ks = 0; ks < 2; ++ks) {
                v2u klo[9], khi[9];
#pragma unroll
                for (int dt = 0; dt < 8; ++dt) { klo[dt] = lds_tr16(kp + 32 * ks * ML_RS + 32 * dt); khi[dt] = lds_tr16(kp + (32 * ks + 4) * ML_RS + 32 * dt); }
                klo[8] = lds_tr16(kp + 32 * ks * ML_RS + 32 * w); khi[8] = lds_tr16(kp + (32 * ks + 4) * ML_RS + 32 * w);
#pragma unroll
                for (int dt = 0; dt < 8; ++dt) accC[dt] = __builtin_amdgcn_mfma_f32_16x16x32_bf16(__builtin_bit_cast(bf16x8, (v4u){klo[dt].x, klo[dt].y, khi[dt].x, khi[dt].y}), vfrag[ks], accC[dt], 0, 0, 0);
                accN = __builtin_amdgcn_mfma_f32_16x16x32_bf16(__builtin_bit_cast(bf16x8, (v4u){klo[8].x, klo[8].y, khi[8].x, khi[8].y}), ones, accN, 0, 0, 0);
            }
            if (fr == 0) *(LAS f32x4*)(LF + MF_NV + 16 * w + 4 * g) = accN;
            }
            mrun = blast + Mlast;
            WG_BAR();
            { ML_OPAQUE();
#pragma unroll
              for (int j = 0; j < 2; ++j) { const int item = tid + NWAVES * 64 * j; const int t = item >> 4, c = item & 15;
                const f32x4 h0 = *(const LAS f32x4*)(L + M2_HT + t * M2_HTS + c * 32), h1 = *(const LAS f32x4*)(L + M2_HT + t * M2_HTS + c * 32 + 16);
                float ss = (h0[0] * h0[0] + h0[1] * h0[1]) + (h0[2] * h0[2] + h0[3] * h0[3]) + (h1[0] * h1[0] + h1[1] * h1[1]) + (h1[2] * h1[2] + h1[3] * h1[3]);
                ss = grp16_sum(ss);
                const float rn = 1.0f / sqrtf(ss * (1.f / 128) + RMS_EPS);
                const v4u og = og2[j]; v4u o;
                o.x = pk2(h0[0] * rn * gn[0][0] * sigmoidf_(bflo(og[0])), h0[1] * rn * gn[0][1] * sigmoidf_(bfhi(og[0])));
                o.y = pk2(h0[2] * rn * gn[0][2] * sigmoidf_(bflo(og[1])), h0[3] * rn * gn[0][3] * sigmoidf_(bfhi(og[1])));
                o.z = pk2(h1[0] * rn * gn[1][0] * sigmoidf_(bflo(og[2])), h1[1] * rn * gn[1][1] * sigmoidf_(bfhi(og[2])));
                o.w = pk2(h1[2] * rn * gn[1][2] * sigmoidf_(bflo(og[3])), h1[3] * rn * gn[1][3] * sigmoidf_(bfhi(og[3])));
                st16_wt(CAT, (unsigned)((size_t)M * 1024 * 2), ((m0 + t) * 1024 + 512 + hh * 128 + 8 * c) * 2, o); } }
        }
        WG_BAR();
    }
#undef M2_PREFETCH
#undef ML_OPAQUE
}

constexpr int G1_RAWK = 0, G1_KWN = 35840, G1_VN = 72704, G1_W = 109568, G1_CW = 110592, G1_RAWQ = 113152, G1_RAWQS = 256;
static_assert(G1_CW + 5 * 128 * 4 <= G1_RAWQ && G1_RAWQ + 131 * G1_RAWQS <= LDSCTL_OFF && ML_NC == 4, "pass-1 LDS map");
__device__ __forceinline__ void mlstm_pass1(Frame& F, const bf16* XIN, const float* gates, bf16* QKc) {
    LAS unsigned char* L = F.lds + RING_OFF; LAS float* WL = (LAS float*)(L + G1_W); LAS float* CW = (LAS float*)(L + G1_CW);
    float* STC = (float*)(F.ws + WS_STC); float* STN = (float*)(F.ws + WS_STN); float* STS = (float*)(F.ws + WS_STS);
    const int lane0 = F.lane, w = F.wave, tid0 = F.tid;
#define G1_OPAQUE() int lane = lane0, tid = tid0; asm volatile("" : "+v"(lane), "+v"(tid)); const int fr = lane & 15, g = lane >> 4; (void)fr; (void)g; (void)tid
    for (int unit = F.vcu; unit < ML_UNITS; unit += F.G) {
        G1_OPAQUE();
        const int bh = unit / ML_G, grp = unit % ML_G; const int b = bh >> 2, hh = bh & 3; const int t0 = grp * 256; const size_t m0 = (size_t)b * SEQ + t0;
        v4u rk[5], rq[5], rv[4];
#define G1_PREFETCH(st_) do { _Pragma("unroll") for (int j = 0; j < 5; ++j) { const int ridx = tid + NWAVES * 64 * j; const int rrow = ridx >> 4, c = ridx & 15; const int tp = t0 + 128 * (st_) - 3 + rrow; \
            rk[j] = (v4u){0u, 0u, 0u, 0u}; rq[j] = (v4u){0u, 0u, 0u, 0u}; if (ridx < 131 * 16 && tp >= 0) { const bf16* row = XIN + (size_t)(b * SEQ + tp) * NIN + hh * 128 + 8 * c; rk[j] = *(const v4u*)(row + C_KM); rq[j] = *(const v4u*)(row + C_QM); } } \
        _Pragma("unroll") for (int j = 0; j < 4; ++j) { const int item = tid + NWAVES * 64 * j; rv[j] = *(const v4u*)(XIN + (m0 + 128 * (st_) + (item >> 4)) * NIN + C_VM + hh * 128 + 8 * (item & 15)); } } while (0)
        G1_PREFETCH(0);
        for (int idx = tid; idx < 640; idx += NWAVES * 64) { const int j = idx >> 7, cl = idx & 127; CW[idx] = j < 4 ? F.w_conv[j * 1024 + 512 + hh * 128 + cl] : F.b_conv[512 + hh * 128 + cl]; }
        float u4[4]; float carry = 0.f, umax = -INFINITY;
#pragma unroll
        for (int j = 0; j < 4; ++j) { const float lf = gates[(m0 + 64 * j + lane) * 8 + 4 + hh], li = gates[(m0 + 64 * j + lane) * 8 + hh];
            const float bc = wave_scan_sum(lf, lane) + carry; carry = lane_bcast(bc, 63); u4[j] = li - bc; umax = fmaxf(umax, u4[j]); }
        umax = fmaxf(umax, dppf_old<DPP_X1>(umax, umax)); umax = fmaxf(umax, dppf_old<DPP_X2>(umax, umax)); umax = fmaxf(umax, dppf_old<DPP_HMIR>(umax, umax)); umax = fmaxf(umax, dppf_old<DPP_MIR>(umax, umax));
        umax = max_x32(max_x16(umax));
        if (w == 0) {
#pragma unroll
            for (int j = 0; j < 4; ++j) WL[64 * j + lane] = __expf(u4[j] - umax); }
        const float Bg = carry, mg = carry + umax;
        f32x4 accC[8], accN;
#pragma unroll
        for (int dt = 0; dt < 8; ++dt) accC[dt] = (f32x4){0.f, 0.f, 0.f, 0.f};
        accN = (f32x4){0.f, 0.f, 0.f, 0.f};
        const bf16x8 ones = __builtin_bit_cast(bf16x8, (v4u){0x3f803f80u, 0x3f803f80u, 0x3f803f80u, 0x3f803f80u});
#pragma unroll 1
        for (int st = 0; st < 2; ++st) {
            { G1_OPAQUE();
#pragma unroll
            for (int j = 0; j < 5; ++j) { const int ridx = tid + NWAVES * 64 * j; if (ridx < 131 * 16) { *(LAS v4u*)(L + G1_RAWK + (ridx >> 4) * ML_RAWS + (ridx & 15) * 16) = rk[j]; *(LAS v4u*)(L + G1_RAWQ + (ridx >> 4) * G1_RAWQS + (ridx & 15) * 16) = rq[j]; } }
#pragma unroll
            for (int j = 0; j < 4; ++j) { const int item = tid + NWAVES * 64 * j; *(LAS v4u*)(L + G1_VN + (item >> 4) * ML_RS + (item & 15) * 16) = rv[j]; }
            if (st == 0) G1_PREFETCH(1);
            }
            WG_BAR();
            { G1_OPAQUE();
            { const int c = tid & 15;
              f32x4 qw[5][2];
#pragma unroll
              for (int j = 0; j < 4; ++j) { qw[j][0] = *(const f32x4*)(F.w_conv + j * 1024 + hh * 128 + 8 * c); qw[j][1] = *(const f32x4*)(F.w_conv + j * 1024 + hh * 128 + 8 * c + 4); }
              qw[4][0] = *(const f32x4*)(F.b_conv + hh * 128 + 8 * c); qw[4][1] = *(const f32x4*)(F.b_conv + hh * 128 + 8 * c + 4);
#pragma unroll 2
              for (int it = 0; it < 4; ++it) { const int s = (tid >> 4) + 32 * it;
                float y[8] = {qw[4][0][0], qw[4][0][1], qw[4][0][2], qw[4][0][3], qw[4][1][0], qw[4][1][1], qw[4][1][2], qw[4][1][3]};
#pragma unroll
                for (int j = 0; j < 4; ++j) { const v4u x = *(const LAS v4u*)(L + G1_RAWQ + (s + j) * G1_RAWQS + c * 16);
                    y[0] += qw[j][0][0] * bflo(x[0]); y[1] += qw[j][0][1] * bfhi(x[0]); y[2] += qw[j][0][2] * bflo(x[1]); y[3] += qw[j][0][3] * bfhi(x[1]);
                    y[4] += qw[j][1][0] * bflo(x[2]); y[5] += qw[j][1][1] * bfhi(x[2]); y[6] += qw[j][1][2] * bflo(x[3]); y[7] += qw[j][1][3] * bfhi(x[3]); }
                v4u o;
#pragma unroll
                for (int e = 0; e < 4; ++e) { float q0 = y[2 * e], q1 = y[2 * e + 1];
                    q0 = q0 * __builtin_amdgcn_rcpf(1.0f + __builtin_amdgcn_exp2f(-1.44269504089f * q0)); q1 = q1 * __builtin_amdgcn_rcpf(1.0f + __builtin_amdgcn_exp2f(-1.44269504089f * q1)); o[e] = pk2(q0, q1); }
                st16_wt(QKc, (unsigned)((size_t)M * 1024 * 2), ((m0 + 128 * st + s) * 1024 + hh * 128 + 8 * c) * 2, o); } }
            { const int c = tid & 15;
              f32x4 cw[5][2];
#pragma unroll
              for (int j = 0; j < 5; ++j) { cw[j][0] = *(const LAS f32x4*)(CW + j * 128 + 8 * c); cw[j][1] = *(const LAS f32x4*)(CW + j * 128 + 8 * c + 4); }
#pragma unroll 2
              for (int it = 0; it < 4; ++it) { const int s = (tid >> 4) + 32 * it;
                const float wsc = WL[128 * st + s];
                float y[8] = {cw[4][0][0], cw[4][0][1], cw[4][0][2], cw[4][0][3], cw[4][1][0], cw[4][1][1], cw[4][1][2], cw[4][1][3]};
#pragma unroll
                for (int j = 0; j < 4; ++j) { const v4u x = *(const LAS v4u*)(L + G1_RAWK + (s + j) * ML_RAWS + c * 16);
                    y[0] += cw[j][0][0] * bflo(x[0]); y[1] += cw[j][0][1] * bfhi(x[0]); y[2] += cw[j][0][2] * bflo(x[1]); y[3] += cw[j][0][3] * bfhi(x[1]);
                    y[4] += cw[j][1][0] * bflo(x[2]); y[5] += cw[j][1][1] * bfhi(x[2]); y[6] += cw[j][1][2] * bflo(x[3]); y[7] += cw[j][1][3] * bfhi(x[3]); }
                v4u o, ow;
#pragma unroll
                for (int e = 0; e < 4; ++e) { float k0 = y[2 * e], k1 = y[2 * e + 1];
                    k0 = k0 * __builtin_amdgcn_rcpf(1.0f + __builtin_amdgcn_exp2f(-1.44269504089f * k0)) * K_SCALE; k1 = k1 * __builtin_amdgcn_rcpf(1.0f + __builtin_amdgcn_exp2f(-1.44269504089f * k1)) * K_SCALE;
                    o[e] = pk2(k0, k1); ow[e] = pk2(k0 * wsc, k1 * wsc); }
                *(LAS v4u*)(L + G1_KWN + s * ML_RS + c * 16) = ow;
                st16_wt(QKc, (unsigned)((size_t)M * 1024 * 2), ((m0 + 128 * st + s) * 1024 + 512 + hh * 128 + 8 * c) * 2, o); } }
            }
            WG_BAR();
            { G1_OPAQUE();
            const LAS unsigned char* kp = L + G1_KWN + (8 * g + (fr >> 2)) * ML_RS + 4 * (fr & 3) * 2;
#pragma unroll
            for (int ks = 0; ks < 4; ++ks) {
                const LAS unsigned char* vp = L + G1_VN + (32 * ks + 8 * g + (fr >> 2)) * ML_RS + (16 * w + 4 * (fr & 3)) * 2;
                const v2u vlo = lds_tr16(vp), vhi = lds_tr16(vp + 4 * ML_RS); const bf16x8 vfrag = __builtin_bit_cast(bf16x8, (v4u){vlo.x, vlo.y, vhi.x, vhi.y});
#pragma unroll
                for (int dt = 0; dt < 8; ++dt) { const v2u lo = lds_tr16(kp + 32 * ks * ML_RS + 32 * dt), hi = lds_tr16(kp + (32 * ks + 4) * ML_RS + 32 * dt);
                    accC[dt] = __builtin_amdgcn_mfma_f32_16x16x32_bf16(__builtin_bit_cast(bf16x8, (v4u){lo.x, lo.y, hi.x, hi.y}), vfrag, accC[dt], 0, 0, 0); }
                const v2u lo = lds_tr16(kp + 32 * ks * ML_RS + 32 * w), hi = lds_tr16(kp + (32 * ks + 4) * ML_RS + 32 * w);
                accN = __builtin_amdgcn_mfma_f32_16x16x32_bf16(__builtin_bit_cast(bf16x8, (v4u){lo.x, lo.y, hi.x, hi.y}), ones, accN, 0, 0, 0);
            }
            }
            WG_BAR();
        }
#pragma unroll
        for (int dt = 0; dt < 8; ++dt) st16_wt(STC, (unsigned)((size_t)ML_UNITS * 16384 * 4), ((size_t)unit * 16384 + ((w * 8 + dt) * 64 + lane) * 4) * 4, __builtin_bit_cast(v4u, accC[dt]));
        if (fr == 0) *(f32x4*)(STN + unit * 128 + 16 * w + 4 * g) = accN;
        if (tid == 0) { STS[unit * 4] = mg; STS[unit * 4 + 1] = Bg; }
#undef G1_PREFETCH
    }
#undef G1_OPAQUE
}
__device__ __forceinline__ void mlstm_scan(Frame& F) {
    float* STC = (float*)(F.ws + WS_STC); float* STN = (float*)(F.ws + WS_STN); float* STS = (float*)(F.ws + WS_STS);
    const int n = 8 * (16384 + 128), stride = F.G * NWAVES * 64;
    for (int idx = (int)blockIdx.x * NWAVES * 64 + F.tid; idx < n; idx += stride) {
        const int bh = idx / (16384 + 128), el = idx % (16384 + 128);
        float m = 0.f, val = 0.f;
        float* const pb = el < 16384 ? STC + (size_t)bh * ML_G * 16384 + el : STN + bh * ML_G * 128 + (el - 16384);
        const int pstr = el < 16384 ? 16384 : 128;
        float xs[ML_G], mgs[ML_G], bgs[ML_G];
#pragma unroll
        for (int gi = 0; gi < ML_G; ++gi) { xs[gi] = pb[(size_t)gi * pstr]; mgs[gi] = STS[(bh * ML_G + gi) * 4]; bgs[gi] = STS[(bh * ML_G + gi) * 4 + 1]; }
#pragma unroll
        for (int gi = 0; gi < ML_G; ++gi) { const int unit = bh * ML_G + gi;
            pb[(size_t)gi * pstr] = val; if (el == 0) STS[unit * 4 + 2] = m;
            const float mn = fmaxf(bgs[gi] + m, mgs[gi]);
            val = __expf(bgs[gi] + m - mn) * val + __expf(mgs[gi] - mn) * xs[gi]; m = mn; }
    }
}
#ifndef P6_ALIGN
#define P6_ALIGN true
#endif
#ifndef P2_ALIGN
#define P2_ALIGN true
#endif
#ifndef GB_MODE
#define GB_MODE 0
#endif
#ifndef REP_LW
#define REP_LW 1
#endif
#ifndef REP_P7
#define REP_P7 1
#endif
#ifndef REP_FB
#define REP_FB 1
#endif
#ifndef REP_BAR_MODE
#define REP_BAR_MODE 0
#endif
#ifndef REP_BAR
#define REP_BAR 0
#endif
#ifndef REP_P0
#define REP_P0 1
#endif
#ifndef REP_P1
#define REP_P1 1
#endif
#ifndef REP_P2
#define REP_P2 1
#endif
#ifndef REP_ML1
#define REP_ML1 1
#endif
#ifndef REP_ATT
#define REP_ATT 1
#endif
#ifndef REP_CMB
#define REP_CMB 1
#endif
#ifndef REP_ML2
#define REP_ML2 1
#endif
#ifndef REP_P4
#define REP_P4 1
#endif
#ifndef REP_P5
#define REP_P5 1
#endif
#ifndef REP_P6
#define REP_P6 1
#endif
struct Args { const float* in[18]; float* out; unsigned char* ws; int ph_lo, ph_hi, li, pad; };
__global__ void __launch_bounds__(NWAVES * 64, 2) blk_fwd(Args args) {
    extern __shared__ __attribute__((aligned(16))) unsigned char lds[];
    Frame F;
    F.lds = (LAS unsigned char*)lds;
    F.MISC = (volatile LAS unsigned*)(F.lds + MISC_OFF);
    F.tid = threadIdx.x; F.lane = F.tid & 63; F.wave = __builtin_amdgcn_readfirstlane(F.tid >> 6);
    F.G = gridDim.x; { const int bx = blockIdx.x; F.vcu = (F.G % 8 == 0) ? (bx % 8) * (F.G / 8) + bx / 8 : bx; }
    unsigned char* ws = args.ws; F.ws = ws;
    F.ctl = (gu32*)(ws + WS_CTL);
    F.x = args.in[0]; F.c = args.in[1]; F.g_mix = args.in[2]; F.w_in = args.in[3]; F.w_conv = args.in[4]; F.b_conv = args.in[5]; F.b_ig = args.in[6]; F.b_fg = args.in[7];
    F.qn_g = args.in[8]; F.kn_g = args.in[9]; F.mn_g = args.in[10]; F.w_out = args.in[11]; F.g_ffn = args.in[12]; F.w_gate = args.in[13]; F.w_up = args.in[14]; F.w_down = args.in[15];
    F.w_ada = args.in[16]; F.b_ada = args.in[17]; F.out = args.out;
    for (int u = F.tid; u < (LDS_BYTES - LDSCTL_OFF) / 4; u += NWAVES * 64) ((LAS unsigned*)(F.lds + LDSCTL_OFF))[u] = 0u;
    __syncthreads();
    const int lo = args.ph_lo, hi = args.ph_hi;
    XcdBarrier bar; bar.bar = (unsigned*)(F.ctl + CW_BAR) + args.li * XCD_BAR_WORDS; bar.x = 0; bar.st = nullptr;
    if (hi - lo > 1) bar = xcd_barrier_post((unsigned*)(F.ctl + CW_BAR) + args.li * XCD_BAR_WORDS, F.MISC + 8);
#define IN(k) (lo <= (k) && (k) < hi)
#define BOTH(k) (IN(k) && IN((k) + 1))
#define GRID_BAR() xcd_barrier<GB_MODE>(bar)
    bf16* Win_t = (bf16*)(ws + WS_WIN); bf16* Wout_t = (bf16*)(ws + WS_WOUT); bf16* Wgu_t = (bf16*)(ws + WS_WGU); bf16* Wdn_t = (bf16*)(ws + WS_WDN);
    bf16* XN = (bf16*)(ws + WS_XN); bf16* XIN = (bf16*)(ws + WS_XIN); bf16* CAT = (bf16*)(ws + WS_CAT); bf16* HB = (bf16*)(ws + WS_H);
    float* mod = (float*)(ws + WS_MOD); float* gates = (float*)(ws + WS_GATES); bf16* X1B = (bf16*)(ws + WS_X1B);

    const bool split0 = (F.G == 256);
    if (IN(0)) { for (int rep = 0; rep < REP_P0; ++rep) { if (!split0) p0_prologue(F); else if (blockIdx.x < 128) p0_mod_wide(F, (int)blockIdx.x); else p0_win_copy(F, 128, 128); } if (BOTH(0)) GRID_BAR(); }
    for (int rep = 0; rep < REP_BAR; ++rep) xcd_barrier<REP_BAR_MODE>(bar);
    if (IN(1)) { if (!split0) { p0_win_copy(F, 0, F.G); __syncthreads(); } for (int rep = 0; rep < REP_P1; ++rep) { norm_rows<true>(F, F.x, F.g_mix, mod + 0 * D, mod + 1 * D, XN, gates); __syncthreads(); } if (BOTH(1)) GRID_BAR(); }
    if (IN(2)) {
        pg8::Gemm g{XN, Win_t, M, NIN, D}; pg8::StaticOrder S; S.init(M, NIN, F.G, (int)blockIdx.x);
        pg8::EpiBf16 E{XIN, NIN, (unsigned)((size_t)M * NIN * 2)};
        for (int rep = 0; rep < REP_P2; ++rep) pg8::gemm_phase<pg8::EpiBf16, pg8::StaticOrder, P2_ALIGN, true>(F.lds + RING_OFF, g, S, E);
        { const int nu = (M / 256) * (NIN / 256); const int first = (nu % F.G) ? (nu % F.G) : 0; __syncthreads(); for (int rep = 0; rep < REP_LW; ++rep) p0_late_weights(F, first); }
        if (BOTH(2)) GRID_BAR();
    }
    if (IN(3)) {
        bf16* OP = (bf16*)F.out; float* LSE = (float*)((unsigned char*)F.out + 48 * MiB);
        for (int rep = 0; rep < REP_ML1; ++rep) mlstm_pass1(F, XIN, gates, XN);
        for (int rep = 0; rep < REP_ATT; ++rep) attn_phase<false>(F, XIN, OP, LSE, CAT, 1024, AT_UNITS);
        GRID_BAR();
        mlstm_scan(F);
        for (int rep = 0; rep < REP_CMB; ++rep) attn_phase<true>(F, XIN, OP, LSE, CAT, 0, 1024);
        GRID_BAR();
        for (int rep = 0; rep < REP_ML2; ++rep) mlstm_pass2(F, XIN, XN, gates, CAT);
        if (BOTH(3)) GRID_BAR();
    }
    if (IN(4)) {
        pg8::Gemm g{CAT, Wout_t, M, D, D}; pg8::StaticOrder S; S.init(M, D, F.G, (int)blockIdx.x);
        pg8::EpiResToB16 E{F.x, X1B, D, mod + 2 * D, NMOD, SEQ, (size_t)M * D * 2};
        for (int rep = 0; rep < REP_P4; ++rep) pg8::gemm_phase<pg8::EpiResToB16, pg8::StaticOrder, true, true>(F.lds + RING_OFF, g, S, E);
        if (BOTH(4)) GRID_BAR();
    }
    if (IN(5)) { for (int rep = 0; rep < REP_P5; ++rep) norm_rows<false, true>(F, (const float*)X1B, F.g_ffn, mod + 3 * D, mod + 4 * D, XN, nullptr); if (BOTH(5)) GRID_BAR(); }
    if (IN(6)) {
        pg8::Gemm g{XN, Wgu_t, M, NGU, D}; pg8::StaticOrder S; S.init(M, NGU, F.G, (int)blockIdx.x, true);
        pg8::EpiSwiGLU E{HB, FF, (unsigned)((size_t)M * FF * 2)};
        for (int rep = 0; rep < REP_P6; ++rep) pg8::gemm_phase<pg8::EpiSwiGLU, pg8::StaticOrder, P6_ALIGN, true>(F.lds + RING_OFF, g, S, E);
        if (BOTH(6)) GRID_BAR();
    }
    if (IN(7)) {
        pg8::Gemm g{HB, Wdn_t, M, D, FF}; pg8::StaticOrder S; S.init(M, D, F.G, (int)blockIdx.x);
        pg8::EpiResFromB16 E{X1B, F.out, D, mod + 5 * D, NMOD, SEQ};
        for (int rep = 0; rep < REP_P7; ++rep) pg8::gemm_phase<pg8::EpiResFromB16, pg8::StaticOrder, true, true>(F.lds + RING_OFF, g, S, E);
    }
#undef IN
#undef BOTH
}

extern "C" void kernel_launch(void* const* d_in, const int* in_sizes, int n_in, void* d_out, int out_size, void* d_ws, size_t ws_size, hipStream_t stream) {
    static int grid = 0;
    if (grid == 0) {
        if (n_in != 18 || out_size != M * D || ws_size < WS_END) { fprintf(stderr, "kernel_launch: unexpected shapes n_in %d out %d ws %zu\n", n_in, out_size, ws_size); grid = -1; return; }
        int dev = 0, cus = 0;
        if (hipGetDevice(&dev) != hipSuccess || hipDeviceGetAttribute(&cus, hipDeviceAttributeMultiprocessorCount, dev) != hipSuccess) { grid = -1; return; }
        if (hipFuncSetAttribute((const void*)blk_fwd, hipFuncAttributeMaxDynamicSharedMemorySize, LDS_BYTES) != hipSuccess) { fprintf(stderr, "kernel_launch: hipFuncSetAttribute failed\n"); grid = -1; return; }
        int per_cu = 0;
        if (hipOccupancyMaxActiveBlocksPerMultiprocessor(&per_cu, (const void*)blk_fwd, NWAVES * 64, LDS_BYTES) != hipSuccess || per_cu < 1) { fprintf(stderr, "kernel_launch: occupancy query reports %d workgroups per CU; nothing launched\n", per_cu); (void)hipGetLastError(); grid = -1; return; }
        grid = cus;
    }
    if (grid < 0) return;
    (void)hipMemsetAsync((char*)d_ws + WS_CTL, 0, CTL_ZERO_BYTES, stream);
    Args a{};
    for (int i = 0; i < 18; ++i) a.in[i] = (const float*)d_in[i];
    a.out = (float*)d_out; a.ws = (unsigned char*)d_ws;
    int li = 0;
    auto run = [&](int lo, int hi) { a.ph_lo = lo; a.ph_hi = hi; a.li = li++; hipLaunchKernelGGL(blk_fwd, dim3(grid), dim3(NWAVES * 64), LDS_BYTES, stream, a); };
    run(0, 8);
}
```

```cpp
#include <hip/hip_runtime.h>
#include <cstdio>
#include <cstdint>

namespace pg8 {
#define PG8_LAS __attribute__((address_space(3)))
typedef unsigned short bf16_t;
typedef short bf16x8 __attribute__((ext_vector_type(8)));
typedef float f32x4 __attribute__((ext_vector_type(4)));
typedef unsigned u32x4 __attribute__((ext_vector_type(4)));
constexpr int BM = 256, BK = 64, HALF = 128, HTB = HALF * BK * 2  , STAGE_BYTES = 8 * HTB, NXCD = 8, WGM = 4;

__host__ __device__ __forceinline__ int lds_byte(int r, int c) { const int st = (r >> 4) * 2 + (c >> 5), rr = r & 15, cc = c & 31, ob = rr * 64 + cc * 2; return st * 1024 + (ob ^ (((ob >> 9) & 1) << 5)); }
__host__ __device__ __forceinline__ void stage_rc(int b, int& R, int& C) { const int st = b / 1024, sb = b % 1024, swz = sb ^ (((sb >> 9) & 1) << 5); R = (st >> 1) * 16 + swz / 64; C = (st & 1) * 32 + (swz % 64) / 2; }
__host__ __device__ __forceinline__ int perm32(int rho) { const int n = rho >> 4, i = rho & 15; return 8 * (i >> 2) + 4 * n + (i & 3); }

struct Unit { int pm, pn, half; };
struct Gemm { const bf16_t* A; const bf16_t* Bt; int M, N, K; };

struct StaticOrder {
    int nM, nN, nwg, G, c; bool half_tail;
    __host__ __device__ __forceinline__ void init(int M, int N, int G_, int c_, bool half_tail_ = false) { nM = M / BM; nN = N / BM; nwg = nM * nN; G = G_; c = c_; half_tail = half_tail_ && (nwg % G_) * 2 == G_; }
    __host__ __device__ __forceinline__ bool next(int i, Unit& u) const {
        long L = (long)i * G + c; u.half = -1;
        if (half_tail && L >= (long)(nwg / G) * G) { if (i > nwg / G) return false; L = (long)(nwg / G) * G + (c >> 1); u.half = c & 1; }
        if (L >= nwg) return false;
        int wgid = (int)L; { const int q = nwg / NXCD, r = nwg % NXCD, xcd = wgid % NXCD, off = wgid / NXCD; wgid = (xcd < r ? xcd * (q + 1) : r * (q + 1) + (xcd - r) * q) + off; }
        const int nig = WGM * nN, gid = wgid / nig, fm = gid * WGM, gsz = (nM - fm) < WGM ? (nM - fm) : WGM;
        u.pm = fm + ((wgid % nig) % gsz); u.pn = (wgid % nig) / gsz; return true;
    }
    __device__ __forceinline__ void a_ready(const Unit&) const {}
    __device__ __forceinline__ void done(const Unit&) const {}
};

__device__ __forceinline__ unsigned cvt_pk_bf16(float lo, float hi) { unsigned r; asm volatile("v_cvt_pk_bf16_f32 %0, %1, %2" : "=v"(r) : "v"(lo), "v"(hi)); return r; }
typedef float f32x2 __attribute__((ext_vector_type(2)));
struct EpiBf16 {
    static constexpr bool PERM = true, AFTER_DRAIN = false;
    bf16_t* O; int ldc; unsigned obytes;
    __device__ __forceinline__ void operator()(const f32x4 (&acc)[2][2][4][2], const Unit& u, int wr, int wc, int fr, int fq) const {
        const int row0 = u.pm * BM + wr * 64 + fr; const int col0 = u.pn * BM + wc * 32 + 8 * fq;
        const __amdgpu_buffer_rsrc_t rs = __builtin_amdgcn_make_buffer_rsrc(O, 0, obytes, 0x00020000);
#pragma unroll
        for (int ai = 0; ai < 2; ++ai)
#pragma unroll
            for (int m = 0; m < 4; ++m) { const unsigned voff = (unsigned)(((size_t)(row0 + ai * HALF + m * 16) * ldc + col0) * 2);
#pragma unroll
                for (int bj = 0; bj < 2; ++bj) { const f32x4 v0 = acc[ai][bj][m][0], v1 = acc[ai][bj][m][1];
                    u32x4 w; w.x = cvt_pk_bf16(v0[0], v0[1]); w.y = cvt_pk_bf16(v0[2], v0[3]); w.z = cvt_pk_bf16(v1[0], v1[1]); w.w = cvt_pk_bf16(v1[2], v1[3]);
                    __builtin_amdgcn_raw_buffer_store_b128(w, rs, voff + bj * HALF * 2, 0, 16); } }
    }
};
struct EpiBf16HM {
    static constexpr bool PERM = true, AFTER_DRAIN = false;
    bf16_t* O; int ldc; unsigned obytes; bf16_t* HM; int seq;
    __device__ __forceinline__ void operator()(const f32x4 (&acc)[2][2][4][2], const Unit& u, int wr, int wc, int fr, int fq) const {
        const int row0 = u.pm * BM + wr * 64 + fr; const int col0 = u.pn * BM + wc * 32 + 8 * fq;
        if (u.pn * BM < 1536) {
            const __amdgpu_buffer_rsrc_t rs = __builtin_amdgcn_make_buffer_rsrc(HM, 0, 3 * 16 * seq * 128, 0x00020000);
            const int b = (u.pm * BM) / seq; const int s0 = row0 - b * seq;
#pragma unroll
            for (int bj = 0; bj < 2; ++bj) { const int col = col0 + bj * HALF; const unsigned pbase = (unsigned)(((((col >> 9) * 2 + b) * 8 + ((col >> 6) & 7)) * seq + s0) * 64 + (col & 63)) * 2u;
#pragma unroll
                for (int ai = 0; ai < 2; ++ai)
#pragma unroll
                    for (int m = 0; m < 4; ++m) { const f32x4 v0 = acc[ai][bj][m][0], v1 = acc[ai][bj][m][1];
                        u32x4 w; w.x = cvt_pk_bf16(v0[0], v0[1]); w.y = cvt_pk_bf16(v0[2], v0[3]); w.z = cvt_pk_bf16(v1[0], v1[1]); w.w = cvt_pk_bf16(v1[2], v1[3]);
                        __builtin_amdgcn_raw_buffer_store_b128(w, rs, pbase + (unsigned)((ai * HALF + m * 16) * 128), 0, 16); } }
            return;
        }
        const __amdgpu_buffer_rsrc_t rs = __builtin_amdgcn_make_buffer_rsrc(O, 0, obytes, 0x00020000);
#pragma unroll
        for (int ai = 0; ai < 2; ++ai)
#pragma unroll
            for (int m = 0; m < 4; ++m) { const unsigned voff = (unsigned)(((size_t)(row0 + ai * HALF + m * 16) * ldc + col0) * 2);
#pragma unroll
                for (int bj = 0; bj < 2; ++bj) { const f32x4 v0 = acc[ai][bj][m][0], v1 = acc[ai][bj][m][1];
                    u32x4 w; w.x = cvt_pk_bf16(v0[0], v0[1]); w.y = cvt_pk_bf16(v0[2], v0[3]); w.z = cvt_pk_bf16(v1[0], v1[1]); w.w = cvt_pk_bf16(v1[2], v1[3]);
                    __builtin_amdgcn_raw_buffer_store_b128(w, rs, voff + bj * HALF * 2, 0, 16); } }
    }
};
__device__ __forceinline__ float silu_f(float x) { return x * __builtin_amdgcn_rcpf(1.0f + __builtin_amdgcn_exp2f(-1.44269504089f * x)); }
struct EpiSwiGLU {
    static constexpr bool PERM = true, AFTER_DRAIN = false;
    bf16_t* O; int ldc; unsigned obytes;
    __device__ __forceinline__ void operator()(const f32x4 (&acc)[2][2][4][2], const Unit& u, int wr, int wc, int fr, int fq) const {
        const int row0 = u.pm * BM + (u.half > 0 ? HALF : 0) + wr * 64 + fr; const int col0 = u.pn * HALF + wc * 32 + 8 * fq;
        const __amdgpu_buffer_rsrc_t rs = __builtin_amdgcn_make_buffer_rsrc(O, 0, obytes, 0x00020000);
#pragma unroll
        for (int ai = 0; ai < 2; ++ai) { if (ai == 1 && u.half >= 0) break;
#pragma unroll
            for (int m = 0; m < 4; ++m) { const unsigned voff = (unsigned)(((size_t)(row0 + ai * HALF + m * 16) * ldc + col0) * 2);
                const f32x4 g0 = acc[ai][0][m][0], g1 = acc[ai][0][m][1], u0 = acc[ai][1][m][0], u1 = acc[ai][1][m][1];
                u32x4 w; w.x = cvt_pk_bf16(silu_f(g0[0]) * u0[0], silu_f(g0[1]) * u0[1]); w.y = cvt_pk_bf16(silu_f(g0[2]) * u0[2], silu_f(g0[3]) * u0[3]);
                w.z = cvt_pk_bf16(silu_f(g1[0]) * u1[0], silu_f(g1[1]) * u1[1]); w.w = cvt_pk_bf16(silu_f(g1[2]) * u1[2], silu_f(g1[3]) * u1[3]);
                __builtin_amdgcn_raw_buffer_store_b128(w, rs, voff, 0, 16); } }
    }
};
template <class Epi, class Sched, bool ALIGN_EPI = false, bool SP2 = false>
__device__ __forceinline__ void gemm_phase(PG8_LAS unsigned char* lds, const Gemm g, const Sched& S, const Epi& E) {
    const int tid = threadIdx.x, wid = __builtin_amdgcn_readfirstlane(tid >> 6), lane = tid & 63, wr = wid >> 2, wc = wid & 3, fr = lane & 15, fq = lane >> 4;
    const int K = g.K, nt = K / BK;
    unsigned voffA[2], voffB[2];
#pragma unroll
    for (int i = 0; i < 2; ++i) { int R, C; stage_rc(tid * 16 + i * 8192, R, C); const int Rb = Epi::PERM ? ((R & ~31) + perm32(R & 31)) : R;
        voffA[i] = (unsigned)(R * K + C) * 2u; voffB[i] = (unsigned)(Rb * K + C) * 2u; }
    const size_t kstep = (size_t)(BK * 2);
    const size_t hstep = (size_t)HALF * K * 2;
    const size_t tstep = 2 * hstep;
    const unsigned ldsw = (unsigned)wid * 1024u;
    const int aoff = lds_byte(wr * 64 + fr, fq * 8), boff = lds_byte(wc * 32 + fr, fq * 8);
#define PG8_SA(b, h) (((b) * 2 + (h)) * HTB)
#define PG8_SB(b, h) ((4 + (b) * 2 + (h)) * HTB)
#define PG8_STAGE(bufoff, gbase, voff) do { _Pragma("unroll") for (int _i = 0; _i < 2; ++_i) \
        __builtin_amdgcn_global_load_lds((const unsigned*)((const char*)(gbase) + (voff)[_i]), (PG8_LAS unsigned*)(lds + (bufoff) + ldsw + _i * 8192), 16, 0, 0); } while (0)
#define PG8_LDA(dst, b, h) do { _Pragma("unroll") for (int m = 0; m < 4; ++m) _Pragma("unroll") for (int k = 0; k < 2; ++k) dst[m][k] = *(const PG8_LAS bf16x8*)(lds + PG8_SA(b, h) + aoff + m * 2048 + k * 1024); } while (0)
#define PG8_LDB(dst, b, h) do { _Pragma("unroll") for (int n = 0; n < 2; ++n) _Pragma("unroll") for (int k = 0; k < 2; ++k) dst[n][k] = *(const PG8_LAS bf16x8*)(lds + PG8_SB(b, h) + boff + n * 2048 + k * 1024); } while (0)
#define PG8_MMA(ai, bj, At, Bt) do { __builtin_amdgcn_s_setprio(1); _Pragma("unroll") for (int m = 0; m < 4; ++m) _Pragma("unroll") for (int n = 0; n < 2; ++n) _Pragma("unroll") for (int k = 0; k < 2; ++k) \
        acc[ai][bj][m][n] = __builtin_amdgcn_mfma_f32_16x16x32_bf16(Bt[n][k], At[m][k], acc[ai][bj][m][n], 0, 0, 0); __builtin_amdgcn_s_setprio(0); } while (0)
#define PG8_WAIT_V(n) asm volatile("s_waitcnt vmcnt(" #n ")" ::: "memory")
#define PG8_WAIT_L(n) asm volatile("s_waitcnt lgkmcnt(" #n ")" ::: "memory")
#define PG8_BAR __builtin_amdgcn_s_barrier()
#define PG8_SCHED __builtin_amdgcn_sched_barrier(0)
    Unit cur, nxt; int ui = 0;
    if (!S.next(0, cur)) return;
    f32x4 acc[2][2][4][2];
#pragma unroll
    for (int a = 0; a < 2; ++a)
#pragma unroll
        for (int b = 0; b < 2; ++b)
#pragma unroll
            for (int m = 0; m < 4; ++m)
#pragma unroll
                for (int n = 0; n < 2; ++n) acc[a][b][m][n] = (f32x4){0.f, 0.f, 0.f, 0.f};
    bf16x8 At[4][2], B0[2][2], B1[2][2];
    const char* cA = (const char*)g.A + (size_t)cur.pm * tstep + (cur.half > 0 ? hstep : 0); const char* cB = (const char*)g.Bt + (size_t)cur.pn * tstep;
    size_t hsAc = cur.half >= 0 ? 0 : hstep;
    S.a_ready(cur);
    if constexpr (SP2) {
        PG8_STAGE(PG8_SB(0, 0), cB, voffB); PG8_STAGE(PG8_SB(0, 1), cB + hstep, voffB); PG8_STAGE(PG8_SA(0, 0), cA, voffA); PG8_STAGE(PG8_SA(0, 1), cA + hsAc, voffA);
        if (wr == 1) PG8_BAR;
        PG8_WAIT_V(2); PG8_BAR;
        PG8_STAGE(PG8_SB(1, 0), cB + kstep, voffB); PG8_STAGE(PG8_SA(1, 0), cA + kstep, voffA); PG8_STAGE(PG8_SB(1, 1), cB + hstep + kstep, voffB);
        PG8_WAIT_V(6); PG8_BAR;
    } else {
        PG8_STAGE(PG8_SB(0, 0), cB, voffB); PG8_STAGE(PG8_SA(0, 0), cA, voffA); PG8_STAGE(PG8_SB(0, 1), cB + hstep, voffB); PG8_STAGE(PG8_SA(0, 1), cA + hstep, voffA);
        if (wr == 1) PG8_BAR;
        PG8_WAIT_V(4); PG8_BAR;
        PG8_STAGE(PG8_SB(1, 0), cB + kstep, voffB); PG8_STAGE(PG8_SA(1, 0), cA + kstep, voffA); PG8_STAGE(PG8_SB(1, 1), cB + hstep + kstep, voffB);
        PG8_WAIT_V(6); PG8_BAR;
    }
    for (;;) {
        const bool has_next = S.next(ui + 1, nxt);
        const char* nA = has_next ? (const char*)g.A + (size_t)nxt.pm * tstep + (nxt.half > 0 ? hstep : 0) : cA; const char* nB = has_next ? (const char*)g.Bt + (size_t)nxt.pn * tstep : cB;
        const size_t hsAn = has_next ? (nxt.half >= 0 ? 0 : hstep) : hsAc; const bool full = cur.half < 0;
        for (int t = 0; t < nt; t += 2) {
            const bool last = (t == nt - 2);
            const char* a1 = cA + (size_t)(t + 1) * kstep;
            const char* a2 = last ? nA : cA + (size_t)(t + 2) * kstep; const char* b2 = last ? nB : cB + (size_t)(t + 2) * kstep;
            const char* a3 = a2 + kstep; const char* b3 = b2 + kstep;
            if (last && has_next) S.a_ready(nxt);
            if constexpr (SP2) {
            PG8_LDB(B0, 0, 0); PG8_LDB(B1, 0, 1); PG8_SCHED; PG8_LDA(At, 0, 0); PG8_STAGE(PG8_SA(1, 1), a1 + hsAc, voffA);
            PG8_WAIT_V(8); PG8_WAIT_L(0); PG8_BAR; PG8_MMA(0, 0, At, B0); PG8_MMA(0, 1, At, B1); PG8_BAR; PG8_SCHED;
            PG8_LDA(At, 0, 1); PG8_STAGE(PG8_SB(0, 0), b2, voffB); PG8_STAGE(PG8_SB(0, 1), b2 + hstep, voffB); PG8_STAGE(PG8_SA(0, 0), a2, voffA);
            PG8_WAIT_V(8); PG8_WAIT_L(0); PG8_BAR; if (full) { PG8_MMA(1, 0, At, B0); PG8_MMA(1, 1, At, B1); } PG8_BAR; PG8_SCHED;
            PG8_LDB(B0, 1, 0); PG8_LDB(B1, 1, 1); PG8_SCHED; PG8_LDA(At, 1, 0); PG8_STAGE(PG8_SA(0, 1), a2 + (last ? hsAn : hsAc), voffA);
            PG8_WAIT_V(8); PG8_WAIT_L(0); PG8_BAR; PG8_MMA(0, 0, At, B0); PG8_MMA(0, 1, At, B1); PG8_BAR; PG8_SCHED;
            PG8_LDA(At, 1, 1); PG8_STAGE(PG8_SB(1, 0), b3, voffB); PG8_STAGE(PG8_SB(1, 1), b3 + hstep, voffB); PG8_STAGE(PG8_SA(1, 0), a3, voffA);
            PG8_WAIT_V(8); PG8_WAIT_L(0); PG8_BAR; if (full) { PG8_MMA(1, 0, At, B0); PG8_MMA(1, 1, At, B1); } PG8_BAR; PG8_SCHED;
            } else {
            PG8_LDB(B0, 0, 0); PG8_SCHED; PG8_LDA(At, 0, 0); PG8_STAGE(PG8_SA(1, 1), a1 + hstep, voffA);
            PG8_WAIT_L(8); PG8_BAR; PG8_WAIT_L(0); PG8_MMA(0, 0, At, B0); PG8_BAR; PG8_SCHED;
            PG8_LDB(B1, 0, 1); PG8_STAGE(PG8_SB(0, 0), b2, voffB);
            PG8_BAR; PG8_WAIT_L(0); PG8_MMA(0, 1, At, B1); PG8_BAR;
            PG8_LDA(At, 0, 1); PG8_STAGE(PG8_SA(0, 0), a2, voffA);
            PG8_BAR; PG8_WAIT_L(0); PG8_MMA(1, 0, At, B0); PG8_BAR; PG8_SCHED;
            PG8_STAGE(PG8_SB(0, 1), b2 + hstep, voffB);
            PG8_WAIT_V(6); PG8_BAR; PG8_MMA(1, 1, At, B1); PG8_BAR;
            PG8_LDB(B0, 1, 0); PG8_SCHED; PG8_LDA(At, 1, 0); PG8_STAGE(PG8_SA(0, 1), a2 + hstep, voffA);
            PG8_WAIT_L(8); PG8_BAR; PG8_WAIT_L(0); PG8_MMA(0, 0, At, B0); PG8_BAR; PG8_SCHED;
            PG8_LDB(B1, 1, 1); PG8_STAGE(PG8_SB(1, 0), b3, voffB);
            PG8_BAR; PG8_WAIT_L(0); PG8_MMA(0, 1, At, B1); PG8_BAR;
            PG8_LDA(At, 1, 1); PG8_STAGE(PG8_SA(1, 0), a3, voffA);
            PG8_BAR; PG8_WAIT_L(0); PG8_MMA(1, 0, At, B0); PG8_BAR; PG8_SCHED;
            PG8_STAGE(PG8_SB(1, 1), b3 + hstep, voffB);
            PG8_WAIT_V(6); PG8_BAR; PG8_MMA(1, 1, At, B1); PG8_BAR;
            }
        }
        if constexpr (ALIGN_EPI) { if (wr == 0) PG8_BAR; }
        if constexpr (!Epi::AFTER_DRAIN) { E(acc, cur, wr, wc, fr, fq); S.done(cur); }
        if (!has_next) break;
#pragma unroll
        for (int a = 0; a < 2; ++a)
#pragma unroll
            for (int b = 0; b < 2; ++b)
#pragma unroll
                for (int m = 0; m < 4; ++m)
#pragma unroll
                    for (int n = 0; n < 2; ++n) acc[a][b][m][n] = (f32x4){0.f, 0.f, 0.f, 0.f};
        cur = nxt; cA = nA; cB = nB; hsAc = hsAn; ++ui;
        if constexpr (ALIGN_EPI) { if (wr == 1) PG8_BAR; }
    }
    PG8_WAIT_V(0);
    if constexpr (!ALIGN_EPI) { if (wr == 0) PG8_BAR; }
    PG8_BAR;
    if constexpr (Epi::AFTER_DRAIN) { E.fused(acc, cur, wr, wc, fr, fq, lds, wid, lane); S.done(cur); }
#undef PG8_SA
#undef PG8_SB
#undef PG8_STAGE
#undef PG8_LDA
#undef PG8_LDB
#undef PG8_MMA
#undef PG8_WAIT_V
#undef PG8_WAIT_L
#undef PG8_BAR
#undef PG8_SCHED
}
}

constexpr int NWAVES = 8;
constexpr int BATCH = 2, SEQ = 8192, D = 1024, M = BATCH * SEQ;
constexpr int INC = 3592, NIN = 3584, FF = 2816, NGU = 2 * FF, NMOD = 6 * D;
constexpr int C_QA = 0, C_KA = 512, C_VA = 1024, C_QM = 1536, C_KM = 2048, C_VM = 2560, C_OG = 3072;
constexpr float RMS_EPS = 1e-6f;
constexpr size_t MiB = 1u << 20;
constexpr size_t WS_CTL = 0, CTL_ZERO_BYTES = 128 * 1024;
constexpr size_t WS_MOD = 64 * 1024;
constexpr size_t WS_GATES = 1 * MiB + 512 * 1024;
constexpr size_t WS_WIN = 2 * MiB, WS_WOUT = 9 * MiB, WS_WGU = 11 * MiB, WS_WDN = 22 * MiB;
constexpr size_t WS_STC = 28 * MiB, WS_STN = 44 * MiB, WS_STS = 44 * MiB + 512 * 1024;
constexpr size_t WS_XN = 48 * MiB;
constexpr size_t WS_CAT = 80 * MiB;
constexpr size_t WS_XIN = 112 * MiB;
constexpr size_t WS_H = 112 * MiB;
constexpr size_t WS_X1B = 200 * MiB;
constexpr int NXM = 2048;
constexpr size_t WS_HM = 176 * MiB;
constexpr size_t WS_AUX = 232 * MiB;
constexpr size_t WS_END = 256 * MiB;
static_assert(WS_WDN + (size_t)D * FF * 2 <= WS_STC && WS_XIN + (size_t)M * NIN * 2 <= 224 * MiB && WS_H + (size_t)M * FF * 2 <= WS_X1B && WS_X1B + (size_t)M * D * 2 <= WS_AUX, "ws map");
constexpr int CW_TMO = 0, CW_CODE = 1, CW_READY = 32, CW_MODCNT = 64, CW_BAR = 4096, CW_RB = 7680  , CW_RB2 = 7936  , CW_RB3 = 1024  , CW_RB1 = 1280  , CW_RB4 = 1536  , CW_RBM = 2048  ;
constexpr unsigned CW_MAGIC = 0x600DF00Du;
constexpr int RING_OFF = 0, RING_BYTES = 131072;
constexpr int LDSCTL_OFF = 147456, MISC_OFF = LDSCTL_OFF + 320;
constexpr int LDS_BYTES = LDSCTL_OFF + 4096;
#define GAS __attribute__((address_space(1)))
#define LAS __attribute__((address_space(3)))
typedef unsigned short bf16;
typedef unsigned v4u __attribute__((ext_vector_type(4)));
typedef unsigned v2u __attribute__((ext_vector_type(2)));
typedef float f32x4 __attribute__((ext_vector_type(4)));
typedef short bf16x8 __attribute__((ext_vector_type(8)));
typedef GAS unsigned gu32;
#define RLX_AGENT __ATOMIC_RELAXED, __HIP_MEMORY_SCOPE_AGENT
#define LDS_WAIT() asm volatile("s_waitcnt lgkmcnt(0)" ::: "memory")
#define VM_WAIT() asm volatile("s_waitcnt vmcnt(0)" ::: "memory")
#define WG_BAR() do { asm volatile("s_waitcnt lgkmcnt(0)" ::: "memory"); __builtin_amdgcn_s_barrier(); asm volatile("" ::: "memory"); } while (0)
typedef __bf16 bf16n2 __attribute__((ext_vector_type(2)));
__device__ __forceinline__ unsigned f2bf(float f) { return (unsigned)__builtin_bit_cast(unsigned short, (__bf16)f); }
__device__ __forceinline__ unsigned pk2(float lo, float hi) { const bf16n2 v = {(__bf16)lo, (__bf16)hi}; return __builtin_bit_cast(unsigned, v); }
typedef short s16x4 __attribute__((ext_vector_type(4)));
__device__ __forceinline__ v2u lds_tr16(const LAS unsigned char* p) { return __builtin_bit_cast(v2u, __builtin_amdgcn_ds_read_tr16_b64_v4i16((LAS s16x4*)p)); }
__device__ __forceinline__ void st16_wt(void* base, unsigned nbytes, size_t byte_off, v4u v) {
    const __amdgpu_buffer_rsrc_t rs = __builtin_amdgcn_make_buffer_rsrc(base, 0, (int)nbytes, 0x00020000);
    __builtin_amdgcn_raw_buffer_store_b128(v, rs, (unsigned)byte_off, 0, 16);
}
__device__ __forceinline__ void st8_wt(void* base, unsigned nbytes, size_t byte_off, v2u v) {
    const __amdgpu_buffer_rsrc_t rs = __builtin_amdgcn_make_buffer_rsrc(base, 0, (int)nbytes, 0x00020000);
    __builtin_amdgcn_raw_buffer_store_b64(v, rs, (unsigned)byte_off, 0, 16);
}
__device__ __forceinline__ void st4_wt(void* base, unsigned nbytes, size_t byte_off, float v) {
    const __amdgpu_buffer_rsrc_t rs = __builtin_amdgcn_make_buffer_rsrc(base, 0, (int)nbytes, 0x00020000);
    __builtin_amdgcn_raw_buffer_store_b32(__builtin_bit_cast(unsigned, v), rs, (unsigned)byte_off, 0, 16);
}
__device__ __forceinline__ float bf2f(unsigned short u) { return __builtin_bit_cast(float, (unsigned)u << 16); }
__device__ __forceinline__ float bflo(unsigned w) { return __builtin_bit_cast(float, w << 16); }
__device__ __forceinline__ float bfhi(unsigned w) { return __builtin_bit_cast(float, w & 0xffff0000u); }
typedef unsigned u32x2_t __attribute__((ext_vector_type(2)));
template <int CTRL> __device__ __forceinline__ float dppf(float v) { return __builtin_bit_cast(float, __builtin_amdgcn_update_dpp(0, __builtin_bit_cast(int, v), CTRL, 0xF, 0xF, true)); }
template <int CTRL> __device__ __forceinline__ float dppf_old(float old, float v) { return __builtin_bit_cast(float, __builtin_amdgcn_update_dpp(__builtin_bit_cast(int, old), __builtin_bit_cast(int, v), CTRL, 0xF, 0xF, false)); }
constexpr int DPP_X1 = 0xB1, DPP_X2 = 0x4E, DPP_HMIR = 0x141, DPP_MIR = 0x140, DPP_ROR8 = 0x128;
__device__ __forceinline__ float sum_x16(float v) { const unsigned b = __builtin_bit_cast(unsigned, v); const u32x2_t r = __builtin_amdgcn_permlane16_swap(b, b, false, false); const unsigned a0 = r[0], a1 = r[1]; return __builtin_bit_cast(float, a0) + __builtin_bit_cast(float, a1); }
__device__ __forceinline__ float sum_x32(float v) { const unsigned b = __builtin_bit_cast(unsigned, v); const u32x2_t r = __builtin_amdgcn_permlane32_swap(b, b, false, false); const unsigned a0 = r[0], a1 = r[1]; return __builtin_bit_cast(float, a0) + __builtin_bit_cast(float, a1); }
__device__ __forceinline__ float max_x16(float v) { const unsigned b = __builtin_bit_cast(unsigned, v); const u32x2_t r = __builtin_amdgcn_permlane16_swap(b, b, false, false); const unsigned a0 = r[0], a1 = r[1]; return fmaxf(__builtin_bit_cast(float, a0), __builtin_bit_cast(float, a1)); }
__device__ __forceinline__ float max_x32(float v) { const unsigned b = __builtin_bit_cast(unsigned, v); const u32x2_t r = __builtin_amdgcn_permlane32_swap(b, b, false, false); const unsigned a0 = r[0], a1 = r[1]; return fmaxf(__builtin_bit_cast(float, a0), __builtin_bit_cast(float, a1)); }
__device__ __forceinline__ float shfl_x16(float v, int lane) { const unsigned b = __builtin_bit_cast(unsigned, v); const u32x2_t r = __builtin_amdgcn_permlane16_swap(b, b, false, false); const unsigned a0 = r[0], a1 = r[1]; return __builtin_bit_cast(float, (lane & 16) ? a0 : a1); }
__device__ __forceinline__ float shfl_x32(float v, int lane) { const unsigned b = __builtin_bit_cast(unsigned, v); const u32x2_t r = __builtin_amdgcn_permlane32_swap(b, b, false, false); const unsigned a0 = r[0], a1 = r[1]; return __builtin_bit_cast(float, (lane & 32) ? a0 : a1); }
__device__ __forceinline__ float grp8_sum(float v) { v += dppf<DPP_X1>(v); v += dppf<DPP_X2>(v); v += dppf<DPP_HMIR>(v); return v; }
__device__ __forceinline__ float grp16_sum(float v) { v = grp8_sum(v); v += dppf<DPP_MIR>(v); return v; }
__device__ __forceinline__ float wave_sum(float v) { v = grp16_sum(v); v = sum_x16(v); return sum_x32(v); }
__device__ __forceinline__ float lane_bcast(float v, int l) { return __builtin_bit_cast(float, __builtin_amdgcn_readlane(__builtin_bit_cast(int, v), l)); }
__device__ __forceinline__ float wave_scan_sum(float v, int lane) {
    v += dppf<0x111>(v); v += dppf<0x112>(v); v += dppf<0x114>(v); v += dppf<0x118>(v);
    const float s0 = lane_bcast(v, 15), s1 = lane_bcast(v, 31), s2 = lane_bcast(v, 47); const int row = lane >> 4;
    return v + (row == 0 ? 0.f : row == 1 ? s0 : row == 2 ? s0 + s1 : (s0 + s1) + s2);
}
__device__ __forceinline__ float wave_scan_max(float v, int lane) {
    const float ninf = -INFINITY;
    v = fmaxf(v, dppf_old<0x111>(ninf, v)); v = fmaxf(v, dppf_old<0x112>(ninf, v)); v = fmaxf(v, dppf_old<0x114>(ninf, v)); v = fmaxf(v, dppf_old<0x118>(ninf, v));
    const float s0 = lane_bcast(v, 15), s1 = lane_bcast(v, 31), s2 = lane_bcast(v, 47); const int row = lane >> 4;
    return fmaxf(v, row == 0 ? ninf : row == 1 ? s0 : row == 2 ? fmaxf(s0, s1) : fmaxf(fmaxf(s0, s1), s2));
}
__device__ __forceinline__ float silu(float x) { return x / (1.0f + __expf(-x)); }
__device__ __forceinline__ float sigmoidf_(float x) { return __builtin_amdgcn_rcpf(1.0f + __builtin_amdgcn_exp2f(-1.44269504089f * x)); }
__device__ __forceinline__ float log_sigmoid(float z) { return fminf(z, 0.f) - log1pf(__expf(-fabsf(z))); }

#define XB_TMO      128
#define XB_XCNT(j)  (256  + 64 * (j))
#define XB_XSUB(j)  (1280 + 64 * (j))
#define XB_XGEN(j)  (2304 + 64 * (j))
#define XB_TOP      3328
#define XB_TOPGEN   3392
#define XCD_BAR_WORDS 3456
#define XB_SPIN_CAP (1u << 18)

__device__ __forceinline__ unsigned xb_ld(unsigned* p)              { return __hip_atomic_load(p, __ATOMIC_RELAXED, __HIP_MEMORY_SCOPE_AGENT); }
__device__ __forceinline__ unsigned xb_add(unsigned* p, unsigned v) { return __hip_atomic_fetch_add(p, v, __ATOMIC_RELAXED, __HIP_MEMORY_SCOPE_AGENT); }
__device__ __forceinline__ unsigned xb_xcc_id() { return (unsigned)__builtin_amdgcn_s_getreg((3 << 11) | 20) & 0xFu; }
#define XB_SPIN(cond, bar) do { unsigned _sp = 0; while (cond) { __builtin_amdgcn_s_sleep(1); \
    if ((++_sp & 255u) == 0u) { if (xb_ld(&(bar)[XB_TMO])) break; if (_sp > XB_SPIN_CAP) { atomicAdd(&(bar)[XB_TMO], 1u); break; } } } } while (0)

struct XcdBarrier {
    unsigned* bar; unsigned x;
    volatile LAS unsigned* st;
};

__device__ __forceinline__ XcdBarrier xcd_barrier_post(unsigned* bar, volatile LAS unsigned* st) {
    XcdBarrier b; b.bar = bar; b.x = xb_xcc_id(); b.st = st;
    if (threadIdx.x == 0) (void)xb_add(&bar[XB_XCNT(b.x)], 1u);
    return b;
}
__device__ __forceinline__ void xcd_barrier_complete(unsigned* bar, unsigned x, unsigned& nloc, unsigned& nx) {
    const unsigned G = gridDim.x * gridDim.y * gridDim.z;
    unsigned sum, cnt, mine, sp = 0u;
    for (;;) {
        sum = 0u; cnt = 0u; mine = 0u;
#pragma unroll
        for (unsigned j = 0; j < 16; ++j) { const unsigned c = xb_ld(&bar[XB_XCNT(j)]); sum += c; cnt += (c > 0u) ? 1u : 0u; mine = (j == x) ? c : mine; }
        if (sum == G) break;
        __builtin_amdgcn_s_sleep(1);
        if ((++sp & 255u) == 0u) { if (xb_ld(&bar[XB_TMO])) break; if (sp > XB_SPIN_CAP) { atomicAdd(&bar[XB_TMO], 1u); break; } }
    }
    nloc = mine > 0u ? mine : 1u; nx = cnt > 0u ? cnt : 1u;
}

template <int MODE = 0>
__device__ __forceinline__ void xcd_barrier(const XcdBarrier& b) {
    asm volatile("s_waitcnt vmcnt(0)" ::: "memory");
    __syncthreads();
    if (threadIdx.x < 64) {
        unsigned* bar = b.bar; const int lane = (int)threadIdx.x;
        unsigned gen = 0u;
        if (lane == 0) {
            __builtin_amdgcn_s_waitcnt(0);
            unsigned nloc = b.st[0], nx = b.st[1];
            if (nloc == 0u) { xcd_barrier_complete(bar, b.x, nloc, nx); unsigned mask = 0u;
#pragma unroll
                for (unsigned j = 0; j < 16; ++j) mask |= (xb_ld(&bar[XB_XCNT(j)]) > 0u ? 1u : 0u) << j;
                b.st[0] = nloc; b.st[1] = nx; b.st[2] = mask; }
            const unsigned old = xb_add(&bar[XB_XSUB(b.x)], 1u);
            gen = old / nloc;
            if (old + 1u == (gen + 1u) * nloc) {
                if (!(MODE & 1)) __builtin_amdgcn_fence(__ATOMIC_RELEASE, "agent");
                asm volatile("s_waitcnt vmcnt(0)" ::: "memory");
                xb_add(&bar[XB_XGEN(b.x)], 1u);
            }
        }
        gen = (unsigned)__builtin_amdgcn_readfirstlane((int)gen);
        const bool watch = lane < 16 && ((b.st[2] >> (lane & 15)) & 1u) != 0u;
        unsigned sp = 0u;
        for (;;) {
            const bool ok = !watch || xb_ld(&bar[XB_XGEN(lane & 15)]) > gen;
            if (__all(ok)) break;
            __builtin_amdgcn_s_sleep(4);
            if ((++sp & 255u) == 0u) { if (__builtin_amdgcn_readfirstlane((int)xb_ld(&bar[XB_TMO])) != 0) break; if (sp > XB_SPIN_CAP) { if (lane == 0) atomicAdd(&bar[XB_TMO], 1u); break; } }
        }
        if (!(MODE & 2)) __builtin_amdgcn_fence(__ATOMIC_ACQUIRE, "agent");
        asm volatile("s_waitcnt vmcnt(0)" ::: "memory");
    }
    __syncthreads();
}
struct Frame {
    LAS unsigned char* lds; volatile LAS unsigned* MISC; gu32* ctl;
    int tid, lane, wave, vcu, G;
    const float *x, *c, *g_mix, *w_in, *w_conv, *b_conv, *b_ig, *b_fg, *qn_g, *kn_g, *mn_g, *w_out, *g_ffn, *w_gate, *w_up, *w_down, *w_ada, *b_ada;
    float* out; unsigned char* ws;
};

template <int MODE>
__device__ __forceinline__ void p0_transpose_item(const float* W, int K, int ldw, int nblk, bf16* WT, unsigned wt_bytes, LAS float* scr, int item, int lane) {
    const int kb = item / nblk, nb = item % nblk, k0 = 64 * kb, n0 = 32 * nb;
    float tv[32];
#pragma unroll
    for (int i = 0; i < 32; ++i) tv[i] = __builtin_nontemporal_load(W + (size_t)(k0 + 2 * i + (lane >> 5)) * ldw + n0 + (lane & 31));
#pragma unroll
    for (int i = 0; i < 32; ++i) scr[(2 * i + (lane >> 5)) * 33 + (lane & 31)] = tv[i];
    LDS_WAIT(); asm volatile("" ::: "memory");
    const int c = lane & 7;
#pragma unroll
    for (int j = 0; j < 4; ++j) { const int n = (lane >> 3) + 8 * j; const LAS float* s = scr + (8 * c) * 33 + n;
        v4u o; o.x = pk2(s[0 * 33], s[1 * 33]); o.y = pk2(s[2 * 33], s[3 * 33]); o.z = pk2(s[4 * 33], s[5 * 33]); o.w = pk2(s[6 * 33], s[7 * 33]);
        int row = n0 + n; if (MODE) row = ((row >> 7) << 8) + (row & 127) + (MODE == 2 ? 128 : 0);
        st16_wt(WT, wt_bytes, ((size_t)row * K + k0 + 8 * c) * 2, o); }
    LDS_WAIT(); asm volatile("" ::: "memory");
}
__device__ __forceinline__ void p0_prologue(Frame& F) {
    {
        LAS float* red = (LAS float*)(F.lds + RING_OFF);
        float* mod = (float*)(F.ws + WS_MOD);
        for (int cg = blockIdx.x; cg < 256; cg += F.G) {
            const int n0 = 24 * cg;
            float acc[2][24];
#pragma unroll
            for (int i = 0; i < 24; ++i) { acc[0][i] = 0.f; acc[1][i] = 0.f; }
            for (int k = F.tid; k < D; k += NWAVES * 64) {
                const float s0 = silu(F.c[k]), s1 = silu(F.c[D + k]);
                const f32x4* wr = (const f32x4*)(F.w_ada + (size_t)k * NMOD + n0);
#pragma unroll
                for (int i = 0; i < 6; ++i) { const f32x4 w = __builtin_nontemporal_load(wr + i);
#pragma unroll
                    for (int e = 0; e < 4; ++e) { acc[0][4 * i + e] += s0 * w[e]; acc[1][4 * i + e] += s1 * w[e]; } }
            }
#pragma unroll
            for (int i = 0; i < 24; ++i) { acc[0][i] = wave_sum(acc[0][i]); acc[1][i] = wave_sum(acc[1][i]); }
            if (F.lane == 0) {
#pragma unroll
                for (int i = 0; i < 24; ++i) { red[F.wave * 48 + i] = acc[0][i]; red[F.wave * 48 + 24 + i] = acc[1][i]; } }
            __syncthreads();
            if (F.tid < 48) { float s = 0.f;
#pragma unroll
                for (int w = 0; w < NWAVES; ++w) s += red[w * 48 + F.tid];
                const int b = F.tid / 24, n = n0 + F.tid % 24; mod[b * NMOD + n] = s + F.b_ada[n]; }
            __syncthreads();
        }
    }
}
__device__ __forceinline__ void p0_mod_wide(Frame& F, int j) {
    LAS float* red = (LAS float*)(F.lds + RING_OFF);
    LAS float* scl = (LAS float*)(F.lds + RING_OFF + 32768);
    float* mod = (float*)(F.ws + WS_MOD);
    const int jc = j & 127, kh = j >> 7, kbeg = kh * (D / 2), kend = kbeg + D / 2;
    for (int i = F.tid; i < 2 * D; i += NWAVES * 64) scl[i] = silu(F.c[i]);
    __syncthreads();
    const int t = F.tid, q = t % 12, r = t / 12;
    if (t < 504) {
        f32x4 a0 = (f32x4){0.f, 0.f, 0.f, 0.f}, a1 = a0;
        const float* wp = F.w_ada + 48 * jc + 4 * q;
#pragma unroll 4
        for (int k = kbeg + r; k < kend; k += 42) { const f32x4 w = __builtin_nontemporal_load((const f32x4*)(wp + (size_t)k * NMOD)); a0 += w * scl[k]; a1 += w * scl[D + k]; }
        *(LAS f32x4*)(red + (r * 12 + q) * 8) = a0; *(LAS f32x4*)(red + (r * 12 + q) * 8 + 4) = a1;
    }
    __syncthreads();
    if (t < 96) { const int b = t / 48, col = t % 48, qq = col >> 2, e = col & 3; float s = kh == 0 ? F.b_ada[48 * jc + col] : 0.f;
        for (int rr = 0; rr < 42; ++rr) s += red[(rr * 12 + qq) * 8 + b * 4 + e];
        (void)__hip_atomic_fetch_add(mod + b * NMOD + 48 * jc + col, s, __ATOMIC_RELAXED, __HIP_MEMORY_SCOPE_AGENT); }
    __syncthreads();
}
__device__ __forceinline__ void p0_win_copy(Frame& F, int wg0, int nwg) {
    LAS float* scr = (LAS float*)(F.lds + RING_OFF + F.wave * 16384);
    if ((int)blockIdx.x < wg0 || (int)blockIdx.x >= wg0 + nwg) return;
    const int gw = ((int)blockIdx.x - wg0) * NWAVES + F.wave, NGW = nwg * NWAVES;
    constexpr int I_IN = (D / 64) * (NIN / 32);
    bf16* Win_t = (bf16*)(F.ws + WS_WIN);
    for (int it = gw; it < I_IN; it += NGW) p0_transpose_item<0>(F.w_in, D, INC, NIN / 32, Win_t, (unsigned)(NIN * D * 2), scr, it, F.lane);
}
__device__ __forceinline__ void p0_late_weights(Frame& F, int first) {
    LAS float* scr = (LAS float*)(F.lds + RING_OFF + F.wave * 16384);
    const int nwg = F.G - first; if ((int)blockIdx.x < first || nwg <= 0) return;
    const int gw = ((int)blockIdx.x - first) * NWAVES + F.wave, NGW = nwg * NWAVES;
    constexpr int I_OUT = (D / 64) * (D / 32), I_G = (D / 64) * (FF / 32), I_DN = (FF / 64) * (D / 32);
    constexpr int NITEMS = I_OUT + 2 * I_G + I_DN;
    bf16* Wout_t = (bf16*)(F.ws + WS_WOUT); bf16* Wgu_t = (bf16*)(F.ws + WS_WGU); bf16* Wdn_t = (bf16*)(F.ws + WS_WDN);
    for (int it = gw; it < NITEMS; it += NGW) {
        int r = it;
        if (r < I_OUT) { p0_transpose_item<0>(F.w_out, D, D, D / 32, Wout_t, (unsigned)(D * D * 2), scr, r, F.lane); continue; } r -= I_OUT;
        if (r < I_G) { p0_transpose_item<1>(F.w_gate, D, FF, FF / 32, Wgu_t, (unsigned)(NGU * D * 2), scr, r, F.lane); continue; } r -= I_G;
        if (r < I_G) { p0_transpose_item<2>(F.w_up, D, FF, FF / 32, Wgu_t, (unsigned)(NGU * D * 2), scr, r, F.lane); continue; } r -= I_G;
        p0_transpose_item<0>(F.w_down, FF, D, D / 32, Wdn_t, (unsigned)(D * FF * 2), scr, r, F.lane);
    }
}
template <bool GATES, bool SRCB16 = false>
__device__ __forceinline__ void norm_rows(Frame& F, const float* src, const float* g, const float* mshift, const float* mscale, bf16* XN, float* gates, bool affine = false, unsigned* modcnt = nullptr, unsigned* tmo = nullptr) {
    LAS float* gwl = (LAS float*)(F.lds + RING_OFF);
    const int gw = affine ? (M / F.G) * F.vcu + F.wave : F.vcu * NWAVES + F.wave, NGW = affine ? NWAVES : F.G * NWAVES, rend = affine ? (M / F.G) * (F.vcu + 1) : M;
    f32x4 v[4], v2[4], nv[4], nv2[4];
#define NR_LOAD(dst, dst2, m_) do { const int ma_ = (m_), mb_ = (m_) + NGW < rend ? (m_) + NGW : (m_); \
        if (SRCB16) { const GAS v2u* xr = (const GAS v2u*)((const bf16*)src + (size_t)ma_ * D) + 2 * F.lane; const GAS v2u* xr2 = (const GAS v2u*)((const bf16*)src + (size_t)mb_ * D) + 2 * F.lane; \
            _Pragma("unroll") for (int j = 0; j < 4; ++j) { const v2u a = xr[128 * (j >> 1) + (j & 1)], b2 = xr2[128 * (j >> 1) + (j & 1)]; dst[j] = (f32x4){bflo(a.x), bfhi(a.x), bflo(a.y), bfhi(a.y)}; dst2[j] = (f32x4){bflo(b2.x), bfhi(b2.x), bflo(b2.y), bfhi(b2.y)}; } } \
        else { const GAS f32x4* xr = (const GAS f32x4*)(src + (size_t)ma_ * D) + 2 * F.lane; const GAS f32x4* xr2 = (const GAS f32x4*)(src + (size_t)mb_ * D) + 2 * F.lane; \
            _Pragma("unroll") for (int j = 0; j < 4; ++j) { dst[j] = __builtin_nontemporal_load(xr + 128 * (j >> 1) + (j & 1)); dst2[j] = __builtin_nontemporal_load(xr2 + 128 * (j >> 1) + (j & 1)); } } } while (0)
    if (gw < rend) NR_LOAD(v, v2, gw);
    LAS float* gsl = gwl + 8 * D;
    if (GATES) {
        for (int i = F.tid; i < 8 * D; i += NWAVES * 64) { const int k = i >> 3, j = i & 7; gwl[j * D + k] = F.w_in[(size_t)k * INC + NIN + j]; }
        if (modcnt) {
            if (F.tid == 0) { unsigned sp = 0u;
                while (__hip_atomic_load(modcnt, __ATOMIC_RELAXED, __HIP_MEMORY_SCOPE_AGENT) < 86u) { __builtin_amdgcn_s_sleep(32);
                    if ((++sp & 63u) == 0u) { if (__hip_atomic_load(tmo, __ATOMIC_RELAXED, __HIP_MEMORY_SCOPE_AGENT)) break; if (sp > (1u << 16)) { atomicAdd(tmo, 1u); break; } } }
                __builtin_amdgcn_fence(__ATOMIC_ACQUIRE, "agent"); }
            __syncthreads();
        }
        for (int i = F.tid; i < 2 * D; i += NWAVES * 64) { const int b = i >> 10, k = i & (D - 1); gsl[b * 2 * D + k] = g[k] * (mscale[(size_t)b * NMOD + k] + 1.0f); gsl[b * 2 * D + D + k] = mshift[(size_t)b * NMOD + k]; }
        __syncthreads();
    }
    f32x4 gs[4], sh[4]; int bcur = -1;
    for (int m = gw; m < rend; m += 2 * NGW) {
        const int m2 = m + NGW; const bool has2 = m2 < rend;
        if (m + 2 * NGW < rend) NR_LOAD(nv, nv2, m + 2 * NGW);
#pragma unroll 1
        for (int half = 0; half < 2; ++half) {
            if (half == 1 && !has2) break;
            const int mm = half ? m2 : m; const int b = mm / SEQ;
            if (!GATES && b != bcur) { bcur = b;
#pragma unroll
                for (int j = 0; j < 4; ++j) { const int k0 = 512 * (j >> 1) + 8 * F.lane + 4 * (j & 1); gs[j] = *(const f32x4*)(g + k0) * (*(const f32x4*)(mscale + (size_t)b * NMOD + k0) + 1.0f); sh[j] = *(const f32x4*)(mshift + (size_t)b * NMOD + k0); } }
            float ss = 0.f;
#pragma unroll
            for (int j = 0; j < 4; ++j) { if (half) v[j] = v2[j]; ss += (v[j].x * v[j].x + v[j].y * v[j].y) + (v[j].z * v[j].z + v[j].w * v[j].w); }
            const float rstd = 1.0f / sqrtf(wave_sum(ss) * (1.f / D) + RMS_EPS);
            float ga[8];
#pragma unroll
            for (int c = 0; c < 8; ++c) ga[c] = 0.f;
            v2u hp = (v2u){0u, 0u};
#pragma unroll
            for (int j = 0; j < 4; ++j) {
                const int k0 = 512 * (j >> 1) + 8 * F.lane + 4 * (j & 1);
                if (GATES) { gs[j] = *(const LAS f32x4*)(gsl + b * 2 * D + k0); sh[j] = *(const LAS f32x4*)(gsl + b * 2 * D + D + k0); }
                const f32x4 h = (v[j] * rstd) * gs[j] + sh[j];
                if (j & 1) st16_wt(XN, (unsigned)((size_t)M * D * 2), ((size_t)mm * D + k0 - 4) * 2, (v4u){hp.x, hp.y, pk2(h.x, h.y), pk2(h.z, h.w)});
                hp = (v2u){pk2(h.x, h.y), pk2(h.z, h.w)};
                if (GATES) {
#pragma unroll
                    for (int c = 0; c < 8; ++c) { const f32x4 w4 = *(const LAS f32x4*)(gwl + c * D + k0); ga[c] += (h.x * w4.x + h.y * w4.y) + (h.z * w4.z + h.w * w4.w); }
                }
            }
            if (GATES) {
                const bool up = F.lane & 32, b4 = F.lane & 16, b3 = F.lane & 8;
                float k4[4], k2[2];
#pragma unroll
                for (int i = 0; i < 4; ++i) { const float snd = up ? ga[i] : ga[4 + i]; k4[i] = (up ? ga[4 + i] : ga[i]) + shfl_x32(snd, F.lane); }
#pragma unroll
                for (int i = 0; i < 2; ++i) { const float snd = b4 ? k4[i] : k4[2 + i]; k2[i] = (b4 ? k4[2 + i] : k4[i]) + shfl_x16(snd, F.lane); }
                float gv = (b3 ? k2[1] : k2[0]) + dppf<DPP_ROR8>(b3 ? k2[0] : k2[1]);
                gv = grp8_sum(gv);
                if ((F.lane & 7) == 0) { const int c = 4 * (F.lane >> 5) + 2 * ((F.lane >> 4) & 1) + ((F.lane >> 3) & 1);
                    gates[(size_t)mm * 8 + c] = c < 4 ? gv + F.b_ig[c] : log_sigmoid(gv + F.b_fg[c - 4]); }
            }
        }
#pragma unroll
        for (int j = 0; j < 4; ++j) { v[j] = nv[j]; v2[j] = nv2[j]; }
    }
#undef NR_LOAD
}
namespace pg8 {
struct EpiResToB16 {
    static constexpr bool PERM = true, AFTER_DRAIN = false;
    const float* base; bf16_t* out; int ldc; const float* gate; int gate_stride; int rows_per_batch; size_t out_bytes;
    __device__ __forceinline__ void operator()(const f32x4 (&acc)[2][2][4][2], const Unit& u, int wr, int wc, int fr, int fq) const {
        const int col0 = u.pn * BM + wc * 32 + 8 * fq; const int b = (u.pm * BM) / rows_per_batch;
        f32x4 gv[2][2];
#pragma unroll
        for (int bj = 0; bj < 2; ++bj)
#pragma unroll
            for (int n = 0; n < 2; ++n) gv[bj][n] = *(const f32x4*)(gate + (size_t)b * gate_stride + col0 + bj * HALF + n * 4);
#pragma unroll
        for (int ai = 0; ai < 2; ++ai)
#pragma unroll
            for (int m = 0; m < 4; ++m) { const size_t off = (size_t)(u.pm * BM + ai * HALF + wr * 64 + m * 16 + fr) * ldc + col0;
#pragma unroll
                for (int bj = 0; bj < 2; ++bj) { const f32x4 b0 = __builtin_nontemporal_load((const f32x4*)(base + off + bj * HALF)), b1 = __builtin_nontemporal_load((const f32x4*)(base + off + bj * HALF + 4));
                    const f32x4 o0 = b0 + gv[bj][0] * acc[ai][bj][m][0], o1 = b1 + gv[bj][1] * acc[ai][bj][m][1];
                    u32x4 w; w.x = cvt_pk_bf16(o0[0], o0[1]); w.y = cvt_pk_bf16(o0[2], o0[3]); w.z = cvt_pk_bf16(o1[0], o1[1]); w.w = cvt_pk_bf16(o1[2], o1[3]);
                    st16_wt(out, (unsigned)out_bytes, (off + bj * HALF) * 2, __builtin_bit_cast(v4u, w)); } }
    }
};
struct EpiResNorm {
    static constexpr bool PERM = true, AFTER_DRAIN = true;
    const float* base; bf16_t* out; bf16_t* xn; int ldc; const float* gate; const float* gffn; const float* shf; const float* scf; int gate_stride; int rows_per_batch; size_t out_bytes;
    float* part; unsigned* cnt; unsigned* tmo; int Mrows; int nN; float eps;
    __device__ __forceinline__ void fused(f32x4 (&acc)[2][2][4][2], const Unit& u, int wr, int wc, int fr, int fq, PG8_LAS unsigned char* lds, int wid, int lane) const {
        const int tid = wid * 64 + lane;
        const int col0 = u.pn * BM + wc * 32 + 8 * fq; const int b = (u.pm * BM) / rows_per_batch;
        PG8_LAS float* rs = (PG8_LAS float*)lds;
        {
            f32x4 gv[2][2];
#pragma unroll
            for (int bj = 0; bj < 2; ++bj)
#pragma unroll
                for (int n = 0; n < 2; ++n) gv[bj][n] = *(const f32x4*)(gate + (size_t)b * gate_stride + col0 + bj * HALF + n * 4);
#pragma unroll
            for (int ai = 0; ai < 2; ++ai)
#pragma unroll
                for (int m = 0; m < 4; ++m) { const size_t off = (size_t)(u.pm * BM + ai * HALF + wr * 64 + m * 16 + fr) * ldc + col0;
                    float s = 0.f;
#pragma unroll
                    for (int bj = 0; bj < 2; ++bj) { const f32x4 b0 = __builtin_nontemporal_load((const f32x4*)(base + off + bj * HALF)), b1 = __builtin_nontemporal_load((const f32x4*)(base + off + bj * HALF + 4));
                        const f32x4 o0 = b0 + gv[bj][0] * acc[ai][bj][m][0], o1 = b1 + gv[bj][1] * acc[ai][bj][m][1];
                        acc[ai][bj][m][0] = o0; acc[ai][bj][m][1] = o1;
                        s += (o0[0] * o0[0] + o0[1] * o0[1]) + (o0[2] * o0[2] + o0[3] * o0[3]) + (o1[0] * o1[0] + o1[1] * o1[1]) + (o1[2] * o1[2] + o1[3] * o1[3]);
                    }
                    s = sum_x32(sum_x16(s));
                    if (fq == (m & 3)) rs[wc * 256 + ai * HALF + wr * 64 + m * 16 + fr] = s; }
        }
        __syncthreads();
        if (tid < 256) { const float s = (rs[tid] + rs[256 + tid]) + (rs[512 + tid] + rs[768 + tid]);
            __hip_atomic_store(part + (size_t)u.pn * Mrows + u.pm * BM + tid, s, __ATOMIC_RELAXED, __HIP_MEMORY_SCOPE_AGENT); }
        asm volatile("s_waitcnt vmcnt(0)" ::: "memory");
        __syncthreads();
        if (tid == 0) {
            unsigned* c = cnt + 4 * u.pm;
            __hip_atomic_fetch_add(c, 1u, __ATOMIC_RELAXED, __HIP_MEMORY_SCOPE_AGENT);
        }
#pragma unroll
        for (int ai = 0; ai < 2; ++ai)
#pragma unroll
            for (int m = 0; m < 4; ++m) { const size_t off = (size_t)(u.pm * BM + ai * HALF + wr * 64 + m * 16 + fr) * ldc + col0;
#pragma unroll
                for (int bj = 0; bj < 2; ++bj) { const f32x4 o0 = acc[ai][bj][m][0], o1 = acc[ai][bj][m][1];
                    u32x4 w; w.x = cvt_pk_bf16(o0[0], o0[1]); w.y = cvt_pk_bf16(o0[2], o0[3]); w.z = cvt_pk_bf16(o1[0], o1[1]); w.w = cvt_pk_bf16(o1[2], o1[3]);
                    st16_wt(out, (unsigned)out_bytes, (off + bj * HALF) * 2, __builtin_bit_cast(v4u, w)); } }
        if (tid == 0) {
            unsigned* c = cnt + 4 * u.pm;
            unsigned sp = 0u;
            while (__hip_atomic_load(c, __ATOMIC_RELAXED, __HIP_MEMORY_SCOPE_AGENT) < (unsigned)nN) { __builtin_amdgcn_s_sleep(1);
                if ((++sp & 255u) == 0u) { if (__hip_atomic_load(tmo, __ATOMIC_RELAXED, __HIP_MEMORY_SCOPE_AGENT)) break; if (sp > (1u << 18)) { atomicAdd(tmo, 1u); break; } } }
        }
        __syncthreads();
        if (tid < 256) { float s = 0.f;
            for (int j = 0; j < nN; ++j) s += __hip_atomic_load(part + (size_t)j * Mrows + u.pm * BM + tid, __ATOMIC_RELAXED, __HIP_MEMORY_SCOPE_AGENT);
            rs[1024 + tid] = 1.0f / sqrtf(s * (1.0f / (float)ldc) + eps); }
        __syncthreads();
        {
            f32x4 gs[2][2], sh[2][2];
#pragma unroll
            for (int bj = 0; bj < 2; ++bj)
#pragma unroll
                for (int n = 0; n < 2; ++n) { const int c = col0 + bj * HALF + n * 4;
                    gs[bj][n] = *(const f32x4*)(gffn + c) * (*(const f32x4*)(scf + (size_t)b * gate_stride + c) + 1.0f); sh[bj][n] = *(const f32x4*)(shf + (size_t)b * gate_stride + c); }
#pragma unroll
            for (int ai = 0; ai < 2; ++ai)
#pragma unroll
                for (int m = 0; m < 4; ++m) { const size_t off = (size_t)(u.pm * BM + ai * HALF + wr * 64 + m * 16 + fr) * ldc + col0;
                    const float rstd = rs[1024 + ai * HALF + wr * 64 + m * 16 + fr];
#pragma unroll
                    for (int bj = 0; bj < 2; ++bj) { const f32x4 h0 = (acc[ai][bj][m][0] * rstd) * gs[bj][0] + sh[bj][0], h1 = (acc[ai][bj][m][1] * rstd) * gs[bj][1] + sh[bj][1];
                        u32x4 w; w.x = cvt_pk_bf16(h0[0], h0[1]); w.y = cvt_pk_bf16(h0[2], h0[3]); w.z = cvt_pk_bf16(h1[0], h1[1]); w.w = cvt_pk_bf16(h1[2], h1[3]);
                        st16_wt(xn, (unsigned)out_bytes, (off + bj * HALF) * 2, __builtin_bit_cast(v4u, w)); } }
        }
    }
};
struct EpiResFromB16 {
    static constexpr bool PERM = true, AFTER_DRAIN = false;
    const bf16_t* base; float* out; int ldc; const float* gate; int gate_stride; int rows_per_batch;
    __device__ __forceinline__ void operator()(const f32x4 (&acc)[2][2][4][2], const Unit& u, int wr, int wc, int fr, int fq) const {
        const int col0 = u.pn * BM + wc * 32 + 8 * fq; const int b = (u.pm * BM) / rows_per_batch;
        f32x4 gv[2][2];
#pragma unroll
        for (int bj = 0; bj < 2; ++bj)
#pragma unroll
            for (int n = 0; n < 2; ++n) gv[bj][n] = *(const f32x4*)(gate + (size_t)b * gate_stride + col0 + bj * HALF + n * 4);
#pragma unroll
        for (int ai = 0; ai < 2; ++ai)
#pragma unroll
            for (int m = 0; m < 4; ++m) { const size_t off = (size_t)(u.pm * BM + ai * HALF + wr * 64 + m * 16 + fr) * ldc + col0;
#pragma unroll
                for (int bj = 0; bj < 2; ++bj) { const u32x4 bw = __builtin_nontemporal_load((const u32x4*)(base + off + bj * HALF));
                    const f32x4 b0 = (f32x4){bflo(bw.x), bfhi(bw.x), bflo(bw.y), bfhi(bw.y)}, b1 = (f32x4){bflo(bw.z), bfhi(bw.z), bflo(bw.w), bfhi(bw.w)};
                    __builtin_nontemporal_store(b0 + gv[bj][0] * acc[ai][bj][m][0], (f32x4*)(out + off + bj * HALF)); __builtin_nontemporal_store(b1 + gv[bj][1] * acc[ai][bj][m][1], (f32x4*)(out + off + bj * HALF + 4)); } }
    }
};
}
constexpr int AT_KROWS = 256, AT_KSTR = 128  , AT_VSTR = 144  ;
constexpr int AT_VT_OFF = AT_KROWS * AT_KSTR, AT_BUF = AT_VT_OFF + AT_KROWS * AT_VSTR;
constexpr int AT_RK_OFF = LDSCTL_OFF + 1024;
static_assert(2 * AT_BUF <= LDSCTL_OFF && AT_RK_OFF + 2 * AT_KROWS * 4 <= LDS_BYTES, "attention LDS double buffer");
constexpr int AT_UNITS = 3 * 16 * 64;
struct AtUnit { int p, b, h, r, rho, i0; };
__device__ __forceinline__ AtUnit at_decode(int u) { AtUnit U; U.p = u >> 10; const int bh = (u >> 6) & 15, cb = u & 63; U.b = bh >> 3; U.h = bh & 7;
    const int sh = 2 * U.p; U.r = 1 << sh; const int nbc = 64 >> sh; U.rho = cb / nbc; U.i0 = 128 * (cb % nbc); return U; }
__device__ __forceinline__ void at_prefetch(const Frame& F, const bf16* XIN, int u, v4u (&pk)[4], v4u (&pv)[4], v4u (&pq)[2]) {
    const AtUnit U = at_decode(u); const int w = F.wave, fr = F.lane & 15, g = F.lane >> 4;
    const int kr0 = F.tid >> 3, c = F.tid & 7;
    const bf16* row0 = XIN + ((long)(U.b * 8 + U.h) * SEQ + (long)(U.i0 - 128 + kr0) * U.r + U.rho) * 64 + 8 * c;
    const long step = (long)64 * U.r * 64; constexpr long C_KA = (long)16 * SEQ * 64, C_VA = (long)32 * SEQ * 64;
#pragma unroll
    for (int it = 0; it < 4; ++it) { pk[it] = (v4u){0u, 0u, 0u, 0u}; pv[it] = (v4u){0u, 0u, 0u, 0u};
        if (U.i0 - 128 + kr0 + 64 * it >= 0) { pk[it] = *(const v4u*)(row0 + it * step + C_KA); pv[it] = *(const v4u*)(row0 + it * step + C_VA); } }
    const bf16* qrow = XIN + ((size_t)(U.b * 8 + U.h) * SEQ + (size_t)(U.i0 + 16 * w + fr) * U.r + U.rho) * 64 + 8 * g;
    pq[0] = *(const v4u*)qrow; pq[1] = *(const v4u*)(qrow + 32);
}
struct AtCarry { bf16x8 qf[2]; };
template <bool CMB>
__device__ __forceinline__ void at_stage(const Frame& F, const bf16* OP, const float* LSE, int u, int buf, const v4u (&pk)[4], const v4u (&pv)[4], const v4u (&pq)[2], const float (&gqk)[16], AtCarry& C) {
    LAS unsigned char* KL = F.lds + RING_OFF + buf * AT_BUF; LAS unsigned char* VL = KL + AT_VT_OFF; LAS float* RK = (LAS float*)(F.lds + AT_RK_OFF) + buf * AT_KROWS;
    const int lane = F.lane, w = F.wave, fr = lane & 15, g = lane >> 4;
    const AtUnit U = at_decode(u);
#pragma unroll
    for (int it = 0; it < 4; ++it) { const int kr = (F.tid >> 3) + 64 * it, c = F.tid & 7;
        const v4u kv = pk[it];
        float ss = 0.f;
#pragma unroll
        for (int e = 0; e < 4; ++e) { const unsigned ke = kv[e]; const bf16n2 k2 = __builtin_bit_cast(bf16n2, ke);     ss = __builtin_amdgcn_fdot2_f32_bf16(k2, k2, ss, false); }
        ss = grp8_sum(ss);
        *(LAS v4u*)(KL + kr * AT_KSTR + ((c ^ (kr & 7)) * 16)) = kv;
        *(LAS v4u*)(VL + kr * AT_VSTR + c * 16) = pv[it];
        if (c == 0) RK[kr] = __builtin_amdgcn_rsqf(ss * (1.f / 64) + RMS_EPS); }
    {
        float qv[16]; float ss = 0.f;
#pragma unroll
        for (int ks = 0; ks < 2; ++ks)
#pragma unroll
            for (int e = 0; e < 4; ++e) { qv[8 * ks + 2 * e] = bflo(pq[ks][e]); qv[8 * ks + 2 * e + 1] = bfhi(pq[ks][e]); }
#pragma unroll
        for (int i = 0; i < 16; ++i) ss += qv[i] * qv[i];
        ss = sum_x32(sum_x16(ss));
        const float rq = (0.125f * 1.44269504089f) * __builtin_amdgcn_rsqf(ss * (1.f / 64) + RMS_EPS);
#pragma unroll
        for (int ks = 0; ks < 2; ++ks) { v4u o;
#pragma unroll
            for (int e = 0; e < 4; ++e) o[e] = pk2(qv[8 * ks + 2 * e] * rq * gqk[8 * ks + 2 * e], qv[8 * ks + 2 * e + 1] * rq * gqk[8 * ks + 2 * e + 1]);
            C.qf[ks] = __builtin_bit_cast(bf16x8, o); }
    }
}
template <bool CMB>
__device__ __forceinline__ void at_compute(const Frame& F, bf16* OP, float* LSE, bf16* CAT, int u, int buf, const AtCarry& C) {
    const LAS unsigned char* KL = F.lds + RING_OFF + buf * AT_BUF; const LAS unsigned char* VL = KL + AT_VT_OFF; const LAS float* RK = (const LAS float*)(F.lds + AT_RK_OFF) + buf * AT_KROWS;
    const int lane = F.lane, w = F.wave, fr = lane & 15, g = lane >> 4;
    const AtUnit U = at_decode(u);
    const size_t mq = (size_t)U.b * SEQ + (size_t)(U.i0 + 16 * w + fr) * U.r + U.rho;
    v2u co[2][4]; float cl[2];
    if (CMB) {
#pragma unroll
        for (int q = 0; q < 2; ++q) { cl[q] = LSE[((size_t)(q + 1) * M + mq) * 8 + U.h];
#pragma unroll
            for (int dt = 0; dt < 4; ++dt) co[q][dt] = *(const v2u*)(OP + ((size_t)(q + 1) * M + mq) * 512 + U.h * 64 + 16 * dt + 4 * g); } }
    f32x4 sacc[9];
#pragma unroll
    for (int kt = 0; kt < 9; ++kt) { sacc[kt] = (f32x4){0.f, 0.f, 0.f, 0.f};
#pragma unroll
        for (int ks = 0; ks < 2; ++ks) { const bf16x8 a = *(const LAS bf16x8*)(KL + (16 * w + 16 * kt + fr) * AT_KSTR + (((4 * ks + g) ^ (fr & 7)) * 16));
            sacc[kt] = __builtin_amdgcn_mfma_f32_16x16x32_bf16(a, C.qf[ks], sacc[kt], 0, 0, 0); }
        sacc[kt] = sacc[kt] * *(const LAS f32x4*)(RK + 16 * w + 16 * kt + 4 * g); }
#pragma unroll
    for (int rr = 0; rr < 4; ++rr) { if (fr > 4 * g + rr) sacc[0][rr] = -INFINITY; if (fr < 4 * g + rr) sacc[8][rr] = -INFINITY; }
    if (U.i0 == 0) {
#pragma unroll
        for (int kt = 0; kt < 9; ++kt)
#pragma unroll
            for (int rr = 0; rr < 4; ++rr) if (16 * w + 16 * kt + 4 * g + rr < 128) sacc[kt][rr] = -INFINITY;
    }
    float mx = -INFINITY;
#pragma unroll
    for (int kt = 0; kt < 9; ++kt) mx = fmaxf(mx, fmaxf(fmaxf(sacc[kt][0], sacc[kt][1]), fmaxf(sacc[kt][2], sacc[kt][3])));
    mx = max_x32(max_x16(mx));
    float lsum = 0.f;
#pragma unroll
    for (int kt = 0; kt < 9; ++kt)
#pragma unroll
        for (int rr = 0; rr < 4; ++rr) { const float pv_ = __builtin_amdgcn_exp2f(sacc[kt][rr] - mx); sacc[kt][rr] = pv_; lsum += pv_; }
    lsum = sum_x32(sum_x16(lsum));
    f32x4 oacc[4];
#pragma unroll
    for (int dt = 0; dt < 4; ++dt) oacc[dt] = (f32x4){0.f, 0.f, 0.f, 0.f};
    const LAS unsigned char* vbase = VL + (16 * w + 4 * g + (fr >> 2)) * AT_VSTR + (fr & 3) * 8;
#pragma unroll
    for (int pp = 0; pp < 5; ++pp) {
        v4u pb; pb.x = pk2(sacc[2 * pp][0], sacc[2 * pp][1]); pb.y = pk2(sacc[2 * pp][2], sacc[2 * pp][3]);
        if (pp < 4) { pb.z = pk2(sacc[2 * pp + 1][0], sacc[2 * pp + 1][1]); pb.w = pk2(sacc[2 * pp + 1][2], sacc[2 * pp + 1][3]); } else { pb.z = 0u; pb.w = 0u; }
        const bf16x8 bfrag = __builtin_bit_cast(bf16x8, pb);
#pragma unroll
        for (int dt = 0; dt < 4; ++dt) { const LAS unsigned char* vr = vbase + (32 * pp) * AT_VSTR + 32 * dt;
            const v2u lo = lds_tr16(vr); v2u hi = (v2u){0u, 0u}; if (pp < 4) hi = lds_tr16(vr + 16 * AT_VSTR);
            const v4u av = (v4u){lo.x, lo.y, hi.x, hi.y};
            oacc[dt] = __builtin_amdgcn_mfma_f32_16x16x32_bf16(__builtin_bit_cast(bf16x8, av), bfrag, oacc[dt], 0, 0, 0); }
    }
    const float inv = __builtin_amdgcn_rcpf(lsum);
    const float lse0 = (mx + __log2f(lsum)) * 0.69314718056f;
    if (CMB) {
        const float mm = fmaxf(lse0, fmaxf(cl[0], cl[1])); float e0 = __expf(lse0 - mm), e1 = __expf(cl[0] - mm), e2 = __expf(cl[1] - mm);
        const float is = __builtin_amdgcn_rcpf(e0 + e1 + e2); e0 *= is * inv; e1 *= is; e2 *= is;
        bf16* crow = CAT + mq * 1024 + U.h * 64 + 4 * g;
#pragma unroll
        for (int dt = 0; dt < 4; ++dt) { v2u o;
            o.x = pk2(e0 * oacc[dt][0] + e1 * bflo(co[0][dt].x) + e2 * bflo(co[1][dt].x), e0 * oacc[dt][1] + e1 * bfhi(co[0][dt].x) + e2 * bfhi(co[1][dt].x));
            o.y = pk2(e0 * oacc[dt][2] + e1 * bflo(co[0][dt].y) + e2 * bflo(co[1][dt].y), e0 * oacc[dt][3] + e1 * bfhi(co[0][dt].y) + e2 * bfhi(co[1][dt].y));
            *(v2u*)(crow + 16 * dt) = o; }
    } else {
        bf16* orow = OP + ((size_t)U.p * M + mq) * 512 + U.h * 64 + 4 * g;
#pragma unroll
        for (int dt = 0; dt < 4; ++dt) { v2u o; o.x = pk2(oacc[dt][0] * inv, oacc[dt][1] * inv); o.y = pk2(oacc[dt][2] * inv, oacc[dt][3] * inv); *(v2u*)(orow + 16 * dt) = o; }
        if (g == 0) LSE[((size_t)U.p * M + mq) * 8 + U.h] = lse0;
    }
}
template <bool CMB>
__device__ __forceinline__ void attn_phase(Frame& F, const bf16* XIN, bf16* OP, float* LSE, bf16* CAT, int ubeg, int uend) {
    const int g = F.lane >> 4;
    float gqk[16];
#pragma unroll
    for (int ks = 0; ks < 2; ++ks)
#pragma unroll
        for (int i = 0; i < 8; ++i) { const int d = 32 * ks + 8 * g + i; gqk[8 * ks + i] = F.qn_g[d] * F.kn_g[d]; }
    const int per = (uend - ubeg + F.G - 1) / F.G; const int u0 = ubeg + F.vcu * per; const int u1 = (u0 + per < uend) ? u0 + per : uend; const int n = u1 - u0;
    if (n <= 0) return;
    v4u pkA[4], pvA[4], pqA[2]; AtCarry cur, nxt;
    at_prefetch(F, XIN, u0, pkA, pvA, pqA);
    at_stage<CMB>(F, OP, LSE, u0, 0, pkA, pvA, pqA, gqk, cur);
    if (n > 1) at_prefetch(F, XIN, u0 + 1, pkA, pvA, pqA);
    WG_BAR();
    for (int i = 0; i < n; i += 2) {
        if (i + 1 < n) { at_stage<CMB>(F, OP, LSE, u0 + i + 1, 1, pkA, pvA, pqA, gqk, nxt); if (i + 2 < n) at_prefetch(F, XIN, u0 + i + 2, pkA, pvA, pqA); }
        at_compute<CMB>(F, OP, LSE, CAT, u0 + i, 0, cur);
        WG_BAR();
        if (i + 1 < n) {
            if (i + 2 < n) { at_stage<CMB>(F, OP, LSE, u0 + i + 2, 0, pkA, pvA, pqA, gqk, cur); if (i + 3 < n) at_prefetch(F, XIN, u0 + i + 3, pkA, pvA, pqA); }
            at_compute<CMB>(F, OP, LSE, CAT, u0 + i + 1, 1, nxt);
            WG_BAR();
        }
    }
}
constexpr int ML_G = 32, ML_NC = 4, ML_UNITS = 8 * ML_G;
static_assert(ML_G * ML_NC * 64 == SEQ, "mLSTM grouping");
constexpr int ML_RS = 288;
constexpr int ML_QN = 0, ML_KN = 18432, ML_KWN = 36864, ML_VN = 55296, ML_SD = 73728, ML_F = 82944, ML_CW = 87552, ML_RAWQ = 92672, ML_RAWK = 110896;
constexpr int ML_RAWS = 272;
static_assert(ML_RAWK + 67 * ML_RAWS <= RING_BYTES, "mLSTM LDS map");
constexpr int MF_U = 0, MF_M = 64, MF_B = 128, MF_RS = 192, MF_QN = 448, MF_NV = 512, MF_HSS = 640;
constexpr float K_SCALE = 0.08838834764831845f;
__device__ __forceinline__ void conv8_lds(const LAS unsigned char* raw, const LAS float* cw, int s, int c, float (&y)[8]) {
    const f32x4 b0 = *(const LAS f32x4*)(cw + 4 * 128 + 8 * c), b1 = *(const LAS f32x4*)(cw + 4 * 128 + 8 * c + 4);
    y[0] = b0[0]; y[1] = b0[1]; y[2] = b0[2]; y[3] = b0[3]; y[4] = b1[0]; y[5] = b1[1]; y[6] = b1[2]; y[7] = b1[3];
#pragma unroll
    for (int j = 0; j < 4; ++j) { const v4u x = *(const LAS v4u*)(raw + (s + j) * ML_RAWS + c * 16);
        const f32x4 w0 = *(const LAS f32x4*)(cw + j * 128 + 8 * c), w1 = *(const LAS f32x4*)(cw + j * 128 + 8 * c + 4);
        y[0] += w0[0] * bflo(x[0]); y[1] += w0[1] * bfhi(x[0]); y[2] += w0[2] * bflo(x[1]); y[3] += w0[3] * bfhi(x[1]);
        y[4] += w1[0] * bflo(x[2]); y[5] += w1[1] * bfhi(x[2]); y[6] += w1[2] * bflo(x[3]); y[7] += w1[3] * bfhi(x[3]); }
#pragma unroll
    for (int i = 0; i < 8; ++i) y[i] = y[i] * __builtin_amdgcn_rcpf(1.0f + __builtin_amdgcn_exp2f(-1.44269504089f * y[i]));
}
constexpr int M2_HT = 87552, M2_HTS = 528;
constexpr int MF_INT = 192, MF_EMT = 256;
static_assert(M2_HT + 64 * M2_HTS <= RING_BYTES, "pass-2 LDS map");
__device__ __forceinline__ void mlstm_pass2(Frame& F, const bf16* XIN, const bf16* QKc, const float* gates, bf16* CAT) {
    LAS unsigned char* L = F.lds + RING_OFF; LAS float* LF = (LAS float*)(L + ML_F);
    float* STC = (float*)(F.ws + WS_STC); float* STN = (float*)(F.ws + WS_STN); float* STS = (float*)(F.ws + WS_STS);
    const int lane0 = F.lane, w = F.wave, tid0 = F.tid;
#define ML_OPAQUE() int lane = lane0, tid = tid0; asm volatile("" : "+v"(lane), "+v"(tid)); const int fr = lane & 15, g = lane >> 4; (void)fr; (void)g; (void)tid
    v4u rq[2], rk[2], rv[2], ro[2]; float glf, gli;
#define M2_PREFETCH(unit_, ck_) do { const int bh_ = (unit_) / ML_G, grp_ = (unit_) % ML_G; const int b_ = bh_ >> 2, hh_ = bh_ & 3; const int t0_ = (grp_ * ML_NC + (ck_)) * 64; \
        ML_OPAQUE(); \
        _Pragma("unroll") for (int j = 0; j < 2; ++j) { const int item = tid + NWAVES * 64 * j; const size_t mr = (size_t)b_ * SEQ + t0_ + (item >> 4); const int c = item & 15; \
            rq[j] = *(const v4u*)(QKc + mr * 1024 + hh_ * 128 + 8 * c); rk[j] = *(const v4u*)(QKc + mr * 1024 + 512 + hh_ * 128 + 8 * c); \
            rv[j] = *(const v4u*)(XIN + mr * NXM + C_VM + hh_ * 128 + 8 * c); ro[j] = *(const v4u*)(XIN + mr * NXM + C_OG + hh_ * 128 + 8 * c); } \
        glf = gates[((size_t)b_ * SEQ + t0_ + lane) * 8 + 4 + hh_]; gli = gates[((size_t)b_ * SEQ + t0_ + lane) * 8 + hh_]; } while (0)
    if (F.vcu < ML_UNITS) M2_PREFETCH(F.vcu, 0);
    for (int unit = F.vcu; unit < ML_UNITS; unit += F.G) {
        const int bh = unit / ML_G, grp = unit % ML_G; const int b = bh >> 2, hh = bh & 3;
        f32x4 accC[8], accN; float mrun; f32x4 gn[2];
        { ML_OPAQUE();
#pragma unroll
          for (int dt = 0; dt < 8; ++dt) accC[dt] = *(const f32x4*)(STC + (size_t)unit * 16384 + ((w * 8 + dt) * 64 + lane) * 4);
          accN = *(const f32x4*)(STN + unit * 128 + 16 * w + 4 * g);
          mrun = STS[unit * 4 + 2]; if (fr == 0) *(LAS f32x4*)(LF + MF_NV + 16 * w + 4 * g) = accN;
          gn[0] = *(const f32x4*)(F.mn_g + hh * 128 + 8 * (tid & 15)); gn[1] = *(const f32x4*)(F.mn_g + hh * 128 + 8 * (tid & 15) + 4); }
#pragma unroll 1
        for (int ck = 0; ck < ML_NC; ++ck) {
            const int t0 = (grp * ML_NC + ck) * 64; const size_t m0 = (size_t)b * SEQ + t0;
            float blast, Mlast, decay; v4u og2[2];
            { ML_OPAQUE();
            const float lf = glf, li = gli;
            const float bc = wave_scan_sum(lf, lane);
            const float u = li - bc;
            const float pm = wave_scan_max(u, lane);
            const float Mt = fmaxf(mrun, pm);
            blast = lane_bcast(bc, 63); Mlast = lane_bcast(Mt, 63);
            const float wv = __expf(u - Mlast); decay = __expf(mrun - Mlast);
            if (w == 0) { LF[MF_U + lane] = u; LF[MF_M + lane] = Mt; LF[MF_INT + lane] = __expf(mrun - Mt); LF[MF_EMT + lane] = __expf(-(bc + Mt)); }
#pragma unroll
            for (int j = 0; j < 2; ++j) { const int item = tid + NWAVES * 64 * j; const int s = item >> 4, c = item & 15;
                const float wsc = __shfl(wv, s);
                *(LAS v4u*)(L + ML_QN + s * ML_RS + c * 16) = rq[j]; *(LAS v4u*)(L + ML_KN + s * ML_RS + c * 16) = rk[j]; *(LAS v4u*)(L + ML_VN + s * ML_RS + c * 16) = rv[j];
                v4u ow;
#pragma unroll
                for (int e = 0; e < 4; ++e) ow[e] = pk2(bflo(rk[j][e]) * wsc, bfhi(rk[j][e]) * wsc);
                *(LAS v4u*)(L + ML_KWN + s * ML_RS + c * 16) = ow; og2[j] = ro[j]; }
            }
            if (ck + 1 < ML_NC) M2_PREFETCH(unit, ck + 1); else if (unit + F.G < ML_UNITS) M2_PREFETCH(unit + F.G, 0);
            WG_BAR();
            bf16x8 vfrag[2];
            { ML_OPAQUE();
#pragma unroll
            for (int ks = 0; ks < 2; ++ks) { const LAS unsigned char* vp = L + ML_VN + (32 * ks + 8 * g + (fr >> 2)) * ML_RS + (16 * w + 4 * (fr & 3)) * 2;
                const v2u lo = lds_tr16(vp), hi = lds_tr16(vp + 4 * ML_RS); vfrag[ks] = __builtin_bit_cast(bf16x8, (v4u){lo.x, lo.y, hi.x, hi.y}); } }
            { ML_OPAQUE(); const int ti = w >> 1; const int t = 16 * ti + fr; const float Mt_t = LF[MF_M + t];
#pragma unroll
              for (int q = 0; q < 2; ++q) { const int si = 2 * (w & 1) + q; f32x4 acc = (f32x4){0.f, 0.f, 0.f, 0.f};
#pragma unroll
                for (int ks = 0; ks < 4; ++ks) { const bf16x8 a = *(const LAS bf16x8*)(L + ML_KN + (16 * si + fr) * ML_RS + (32 * ks + 8 * g) * 2);
                    const bf16x8 bq = *(const LAS bf16x8*)(L + ML_QN + (16 * ti + fr) * ML_RS + (32 * ks + 8 * g) * 2);
                    acc = __builtin_amdgcn_mfma_f32_16x16x32_bf16(a, bq, acc, 0, 0, 0); }
                const f32x4 us = *(const LAS f32x4*)(LF + MF_U + 16 * si + 4 * g); float sd[4];
#pragma unroll
                for (int rr = 0; rr < 4; ++rr) { const int s = 16 * si + 4 * g + rr; sd[rr] = (s <= t) ? acc[rr] * __expf(us[rr] - Mt_t) : 0.f; }
                v2u o; o.x = pk2(sd[0], sd[1]); o.y = pk2(sd[2], sd[3]);
                *(LAS v2u*)(L + ML_SD + t * 144 + (16 * si + 4 * g) * 2) = o; } }
            WG_BAR();
            { ML_OPAQUE();
            f32x4 hacc[4], qacc[4], racc[4];
#pragma unroll
            for (int ti = 0; ti < 4; ++ti) { hacc[ti] = (f32x4){0.f, 0.f, 0.f, 0.f}; qacc[ti] = (f32x4){0.f, 0.f, 0.f, 0.f}; racc[ti] = (f32x4){0.f, 0.f, 0.f, 0.f}; }
            bf16x8 qfr[4][4]; f32x4 nv0[4], nv1[4];
#pragma unroll
            for (int ks = 0; ks < 4; ++ks) { nv0[ks] = *(const LAS f32x4*)(LF + MF_NV + 32 * ks + 4 * g); nv1[ks] = *(const LAS f32x4*)(LF + MF_NV + 32 * ks + 16 + 4 * g);
#pragma unroll
                for (int ti = 0; ti < 4; ++ti) { const LAS unsigned char* qp = L + ML_QN + (16 * ti + fr) * ML_RS + (32 * ks + 4 * g) * 2;
                    const v2u lo = *(const LAS v2u*)qp, hi = *(const LAS v2u*)(qp + 32); qfr[ks][ti] = __builtin_bit_cast(bf16x8, (v4u){lo.x, lo.y, hi.x, hi.y}); } }
#pragma unroll
            for (int ks = 0; ks < 4; ++ks) {
                v4u cb; cb.x = pk2(accC[2 * ks][0], accC[2 * ks][1]); cb.y = pk2(accC[2 * ks][2], accC[2 * ks][3]); cb.z = pk2(accC[2 * ks + 1][0], accC[2 * ks + 1][1]); cb.w = pk2(accC[2 * ks + 1][2], accC[2 * ks + 1][3]);
                const bf16x8 cfrag = __builtin_bit_cast(bf16x8, cb);
                v4u nb; nb.x = pk2(nv0[ks][0], nv0[ks][1]); nb.y = pk2(nv0[ks][2], nv0[ks][3]); nb.z = pk2(nv1[ks][0], nv1[ks][1]); nb.w = pk2(nv1[ks][2], nv1[ks][3]);
                const bf16x8 nfrag = __builtin_bit_cast(bf16x8, nb);
#pragma unroll
                for (int ti = 0; ti < 4; ++ti) {
                    hacc[ti] = __builtin_amdgcn_mfma_f32_16x16x32_bf16(qfr[ks][ti], cfrag, hacc[ti], 0, 0, 0);
                    qacc[ti] = __builtin_amdgcn_mfma_f32_16x16x32_bf16(qfr[ks][ti], nfrag, qacc[ti], 0, 0, 0); }
            }
            f32x4 inter[4];
#pragma unroll
            for (int ti = 0; ti < 4; ++ti) { inter[ti] = *(const LAS f32x4*)(LF + MF_INT + 16 * ti + 4 * g); hacc[ti] = hacc[ti] * inter[ti]; }
            const bf16x8 ones = __builtin_bit_cast(bf16x8, (v4u){0x3f803f80u, 0x3f803f80u, 0x3f803f80u, 0x3f803f80u});
            bf16x8 sdf[2][4];
#pragma unroll
            for (int ks = 0; ks < 2; ++ks)
#pragma unroll
                for (int ti = 0; ti < 4; ++ti) sdf[ks][ti] = *(const LAS bf16x8*)(L + ML_SD + (16 * ti + fr) * 144 + (32 * ks + 8 * g) * 2);
#pragma unroll
            for (int ks = 0; ks < 2; ++ks)
#pragma unroll
                for (int ti = 0; ti < 4; ++ti) {
                    hacc[ti] = __builtin_amdgcn_mfma_f32_16x16x32_bf16(sdf[ks][ti], vfrag[ks], hacc[ti], 0, 0, 0);
                    racc[ti] = __builtin_amdgcn_mfma_f32_16x16x32_bf16(sdf[ks][ti], ones, racc[ti], 0, 0, 0); }
#pragma unroll
            for (int ti = 0; ti < 4; ++ti) { const f32x4 emt = *(const LAS f32x4*)(LF + MF_EMT + 16 * ti + 4 * g);
#pragma unroll
                for (int rr = 0; rr < 4; ++rr) { const float den = fmaxf(fabsf(inter[ti][rr] * qacc[ti][rr] + racc[ti][rr]), emt[rr]);
                    *(LAS float*)(L + M2_HT + (16 * ti + 4 * g + rr) * M2_HTS + (16 * w + fr) * 4) = hacc[ti][rr] * __builtin_amdgcn_rcpf(den); } }
            const LAS unsigned char* kp = L + ML_KWN + (8 * g + (fr >> 2)) * ML_RS + 4 * (fr & 3) * 2;
#pragma unroll
            for (int dt = 0; dt < 8; ++dt) accC[dt] = accC[dt] * decay;
            accN = accN * decay;
#pragma unroll
            for (int ks = 0; ks < 2; ++ks) {
                v2u klo[9], khi[9];
#pragma unroll
                for (int dt = 0; dt < 8; ++dt) { klo[dt] = lds_tr16(kp + 32 * ks * ML_RS + 32 * dt); khi[dt] = lds_tr16(kp + (32 * ks + 4) * ML_RS + 32 * dt); }
                klo[8] = lds_tr16(kp + 32 * ks * ML_RS + 32 * w); khi[8] = lds_tr16(kp + (32 * ks + 4) * ML_RS + 32 * w);
#pragma unroll
                for (int dt = 0; dt < 8; ++dt) accC[dt] = __builtin_amdgcn_mfma_f32_16x16x32_bf16(__builtin_bit_cast(bf16x8, (v4u){klo[dt].x, klo[dt].y, khi[dt].x, khi[dt].y}), vfrag[ks], accC[dt], 0, 0, 0);
                accN = __builtin_amdgcn_mfma_f32_16x16x32_bf16(__builtin_bit_cast(bf16x8, (v4u){klo[8].x, klo[8].y, khi[8].x, khi[8].y}), ones, accN, 0, 0, 0);
            }
            if (fr == 0) *(LAS f32x4*)(LF + MF_NV + 16 * w + 4 * g) = accN;
            }
            mrun = blast + Mlast;
            WG_BAR();
            { ML_OPAQUE();
#pragma unroll
              for (int j = 0; j < 2; ++j) { const int item = tid + NWAVES * 64 * j; const int t = item >> 4, c = item & 15;
                const f32x4 h0 = *(const LAS f32x4*)(L + M2_HT + t * M2_HTS + c * 32), h1 = *(const LAS f32x4*)(L + M2_HT + t * M2_HTS + c * 32 + 16);
                float ss = (h0[0] * h0[0] + h0[1] * h0[1]) + (h0[2] * h0[2] + h0[3] * h0[3]) + (h1[0] * h1[0] + h1[1] * h1[1]) + (h1[2] * h1[2] + h1[3] * h1[3]);
                ss = grp16_sum(ss);
                const float rn = __builtin_amdgcn_rsqf(ss * (1.f / 128) + RMS_EPS);
                const v4u og = og2[j]; v4u o;
                o.x = pk2(h0[0] * rn * gn[0][0] * sigmoidf_(bflo(og[0])), h0[1] * rn * gn[0][1] * sigmoidf_(bfhi(og[0])));
                o.y = pk2(h0[2] * rn * gn[0][2] * sigmoidf_(bflo(og[1])), h0[3] * rn * gn[0][3] * sigmoidf_(bfhi(og[1])));
                o.z = pk2(h1[0] * rn * gn[1][0] * sigmoidf_(bflo(og[2])), h1[1] * rn * gn[1][1] * sigmoidf_(bfhi(og[2])));
                o.w = pk2(h1[2] * rn * gn[1][2] * sigmoidf_(bflo(og[3])), h1[3] * rn * gn[1][3] * sigmoidf_(bfhi(og[3])));
                st16_wt(CAT, (unsigned)((size_t)M * 1024 * 2), ((m0 + t) * 1024 + 512 + hh * 128 + 8 * c) * 2, o); } }
        }
        WG_BAR();
    }
#undef M2_PREFETCH
#undef ML_OPAQUE
}

constexpr int G1_RAWK = 0, G1_KWN = 35840, G1_VN = 72704, G1_W = 109568, G1_CW = 110592, G1_RAWQ = 113152, G1_RAWQS = 256;
static_assert(G1_CW + 5 * 128 * 4 <= G1_RAWQ && G1_RAWQ + 131 * G1_RAWQS <= LDSCTL_OFF && ML_NC == 4, "pass-1 LDS map");
__device__ __forceinline__ void mlstm_pass1(Frame& F, const bf16* XIN, const float* gates, bf16* QKc) {
    LAS unsigned char* L = F.lds + RING_OFF; LAS float* WL = (LAS float*)(L + G1_W); LAS float* CW = (LAS float*)(L + G1_CW); LAS float* CWQ = (LAS float*)(F.lds + LDSCTL_OFF + 1024);
    float* STC = (float*)(F.ws + WS_STC); float* STN = (float*)(F.ws + WS_STN); float* STS = (float*)(F.ws + WS_STS);
    const int lane0 = F.lane, w = F.wave, tid0 = F.tid;
#define G1_OPAQUE() int lane = lane0, tid = tid0; asm volatile("" : "+v"(lane), "+v"(tid)); const int fr = lane & 15, g = lane >> 4; (void)fr; (void)g; (void)tid
    for (int unit = F.vcu; unit < ML_UNITS; unit += F.G) {
        G1_OPAQUE();
        const int bh = unit / ML_G, grp = unit % ML_G; const int b = bh >> 2, hh = bh & 3; const int t0 = grp * 256; const size_t m0 = (size_t)b * SEQ + t0;
        v4u rk[5], rq[5], rv[4];
#define G1_PREFETCH(st_) do { _Pragma("unroll") for (int j = 0; j < 5; ++j) { const int ridx = tid + NWAVES * 64 * j; const int rrow = ridx >> 4, c = ridx & 15; const int tp = t0 + 128 * (st_) - 3 + rrow; \
            rk[j] = (v4u){0u, 0u, 0u, 0u}; rq[j] = (v4u){0u, 0u, 0u, 0u}; if (ridx < 131 * 16 && tp >= 0) { const bf16* row = XIN + (size_t)(b * SEQ + tp) * NXM + hh * 128 + 8 * c; rk[j] = *(const v4u*)(row + C_KM); rq[j] = *(const v4u*)(row + C_QM); } } \
        _Pragma("unroll") for (int j = 0; j < 4; ++j) { const int item = tid + NWAVES * 64 * j; rv[j] = *(const v4u*)(XIN + (m0 + 128 * (st_) + (item >> 4)) * NXM + C_VM + hh * 128 + 8 * (item & 15)); } } while (0)
        G1_PREFETCH(0);
        for (int idx = tid; idx < 640; idx += NWAVES * 64) { const int j = idx >> 7, cl = idx & 127; CW[idx] = j < 4 ? F.w_conv[j * 1024 + 512 + hh * 128 + cl] : F.b_conv[512 + hh * 128 + cl];
            CWQ[idx] = j < 4 ? F.w_conv[j * 1024 + hh * 128 + cl] : F.b_conv[hh * 128 + cl]; }
        float u4[4]; float carry = 0.f, umax = -INFINITY;
#pragma unroll
        for (int j = 0; j < 4; ++j) { const float lf = gates[(m0 + 64 * j + lane) * 8 + 4 + hh], li = gates[(m0 + 64 * j + lane) * 8 + hh];
            const float bc = wave_scan_sum(lf, lane) + carry; carry = lane_bcast(bc, 63); u4[j] = li - bc; umax = fmaxf(umax, u4[j]); }
        umax = fmaxf(umax, dppf_old<DPP_X1>(umax, umax)); umax = fmaxf(umax, dppf_old<DPP_X2>(umax, umax)); umax = fmaxf(umax, dppf_old<DPP_HMIR>(umax, umax)); umax = fmaxf(umax, dppf_old<DPP_MIR>(umax, umax));
        umax = max_x32(max_x16(umax));
        if (w == 0) {
#pragma unroll
            for (int j = 0; j < 4; ++j) WL[64 * j + lane] = __expf(u4[j] - umax); }
        const float Bg = carry, mg = carry + umax;
        f32x4 accC[8], accN;
#pragma unroll
        for (int dt = 0; dt < 8; ++dt) accC[dt] = (f32x4){0.f, 0.f, 0.f, 0.f};
        accN = (f32x4){0.f, 0.f, 0.f, 0.f};
        const bf16x8 ones = __builtin_bit_cast(bf16x8, (v4u){0x3f803f80u, 0x3f803f80u, 0x3f803f80u, 0x3f803f80u});
#pragma unroll 1
        for (int st = 0; st < 2; ++st) {
            { G1_OPAQUE();
#pragma unroll
            for (int j = 0; j < 5; ++j) { const int ridx = tid + NWAVES * 64 * j; if (ridx < 131 * 16) { *(LAS v4u*)(L + G1_RAWK + (ridx >> 4) * ML_RAWS + (ridx & 15) * 16) = rk[j]; *(LAS v4u*)(L + G1_RAWQ + (ridx >> 4) * G1_RAWQS + (ridx & 15) * 16) = rq[j]; } }
#pragma unroll
            for (int j = 0; j < 4; ++j) { const int item = tid + NWAVES * 64 * j; *(LAS v4u*)(L + G1_VN + (item >> 4) * ML_RS + (item & 15) * 16) = rv[j]; }
            if (st == 0) G1_PREFETCH(1);
            }
            WG_BAR();
            { G1_OPAQUE();
            { const int c = tid & 15;
              f32x4 qw[5][2];
#pragma unroll
              for (int j = 0; j < 5; ++j) { qw[j][0] = *(const LAS f32x4*)(CWQ + j * 128 + 8 * c); qw[j][1] = *(const LAS f32x4*)(CWQ + j * 128 + 8 * c + 4); }
#pragma unroll 2
              for (int it = 0; it < 4; ++it) { const int s = (tid >> 4) + 32 * it;
                float y[8] = {qw[4][0][0], qw[4][0][1], qw[4][0][2], qw[4][0][3], qw[4][1][0], qw[4][1][1], qw[4][1][2], qw[4][1][3]};
#pragma unroll
                for (int j = 0; j < 4; ++j) { const v4u x = *(const LAS v4u*)(L + G1_RAWQ + (s + j) * G1_RAWQS + c * 16);
                    y[0] += qw[j][0][0] * bflo(x[0]); y[1] += qw[j][0][1] * bfhi(x[0]); y[2] += qw[j][0][2] * bflo(x[1]); y[3] += qw[j][0][3] * bfhi(x[1]);
                    y[4] += qw[j][1][0] * bflo(x[2]); y[5] += qw[j][1][1] * bfhi(x[2]); y[6] += qw[j][1][2] * bflo(x[3]); y[7] += qw[j][1][3] * bfhi(x[3]); }
                v4u o;
#pragma unroll
                for (int e = 0; e < 4; ++e) { float q0 = y[2 * e], q1 = y[2 * e + 1];
                    q0 = q0 * __builtin_amdgcn_rcpf(1.0f + __builtin_amdgcn_exp2f(-1.44269504089f * q0)); q1 = q1 * __builtin_amdgcn_rcpf(1.0f + __builtin_amdgcn_exp2f(-1.44269504089f * q1)); o[e] = pk2(q0, q1); }
                st16_wt(QKc, (unsigned)((size_t)M * 1024 * 2), ((m0 + 128 * st + s) * 1024 + hh * 128 + 8 * c) * 2, o); } }
            { const int c = tid & 15;
              f32x4 cw[5][2];
#pragma unroll
              for (int j = 0; j < 5; ++j) { cw[j][0] = *(const LAS f32x4*)(CW + j * 128 + 8 * c); cw[j][1] = *(const LAS f32x4*)(CW + j * 128 + 8 * c + 4); }
#pragma unroll 2
              for (int it = 0; it < 4; ++it) { const int s = (tid >> 4) + 32 * it;
                const float wsc = WL[128 * st + s];
                float y[8] = {cw[4][0][0], cw[4][0][1], cw[4][0][2], cw[4][0][3], cw[4][1][0], cw[4][1][1], cw[4][1][2], cw[4][1][3]};
#pragma unroll
                for (int j = 0; j < 4; ++j) { const v4u x = *(const LAS v4u*)(L + G1_RAWK + (s + j) * ML_RAWS + c * 16);
                    y[0] += cw[j][0][0] * bflo(x[0]); y[1] += cw[j][0][1] * bfhi(x[0]); y[2] += cw[j][0][2] * bflo(x[1]); y[3] += cw[j][0][3] * bfhi(x[1]);
                    y[4] += cw[j][1][0] * bflo(x[2]); y[5] += cw[j][1][1] * bfhi(x[2]); y[6] += cw[j][1][2] * bflo(x[3]); y[7] += cw[j][1][3] * bfhi(x[3]); }
                v4u o, ow;
#pragma unroll
                for (int e = 0; e < 4; ++e) { float k0 = y[2 * e], k1 = y[2 * e + 1];
                    k0 = k0 * __builtin_amdgcn_rcpf(1.0f + __builtin_amdgcn_exp2f(-1.44269504089f * k0)) * K_SCALE; k1 = k1 * __builtin_amdgcn_rcpf(1.0f + __builtin_amdgcn_exp2f(-1.44269504089f * k1)) * K_SCALE;
                    o[e] = pk2(k0, k1); ow[e] = pk2(k0 * wsc, k1 * wsc); }
                *(LAS v4u*)(L + G1_KWN + s * ML_RS + c * 16) = ow;
                st16_wt(QKc, (unsigned)((size_t)M * 1024 * 2), ((m0 + 128 * st + s) * 1024 + 512 + hh * 128 + 8 * c) * 2, o); } }
            }
            WG_BAR();
            { G1_OPAQUE();
            const LAS unsigned char* kp = L + G1_KWN + (8 * g + (fr >> 2)) * ML_RS + 4 * (fr & 3) * 2;
#pragma unroll
            for (int ks = 0; ks < 4; ++ks) {
                const LAS unsigned char* vp = L + G1_VN + (32 * ks + 8 * g + (fr >> 2)) * ML_RS + (16 * w + 4 * (fr & 3)) * 2;
                const v2u vlo = lds_tr16(vp), vhi = lds_tr16(vp + 4 * ML_RS); const bf16x8 vfrag = __builtin_bit_cast(bf16x8, (v4u){vlo.x, vlo.y, vhi.x, vhi.y});
#pragma unroll
                for (int dt = 0; dt < 8; ++dt) { const v2u lo = lds_tr16(kp + 32 * ks * ML_RS + 32 * dt), hi = lds_tr16(kp + (32 * ks + 4) * ML_RS + 32 * dt);
                    accC[dt] = __builtin_amdgcn_mfma_f32_16x16x32_bf16(__builtin_bit_cast(bf16x8, (v4u){lo.x, lo.y, hi.x, hi.y}), vfrag, accC[dt], 0, 0, 0); }
                const v2u lo = lds_tr16(kp + 32 * ks * ML_RS + 32 * w), hi = lds_tr16(kp + (32 * ks + 4) * ML_RS + 32 * w);
                accN = __builtin_amdgcn_mfma_f32_16x16x32_bf16(__builtin_bit_cast(bf16x8, (v4u){lo.x, lo.y, hi.x, hi.y}), ones, accN, 0, 0, 0);
            }
            }
            WG_BAR();
        }
#pragma unroll
        for (int dt = 0; dt < 8; ++dt) st16_wt(STC, (unsigned)((size_t)ML_UNITS * 16384 * 4), ((size_t)unit * 16384 + ((w * 8 + dt) * 64 + lane) * 4) * 4, __builtin_bit_cast(v4u, accC[dt]));
        if (fr == 0) *(f32x4*)(STN + unit * 128 + 16 * w + 4 * g) = accN;
        if (tid == 0) { STS[unit * 4] = mg; STS[unit * 4 + 1] = Bg; }
#undef G1_PREFETCH
    }
#undef G1_OPAQUE
}
__device__ __forceinline__ void mlstm_scan(Frame& F) {
    float* STC = (float*)(F.ws + WS_STC); float* STN = (float*)(F.ws + WS_STN); float* STS = (float*)(F.ws + WS_STS);
    const int n = 8 * 16384, stride = F.G * NWAVES * 64;
    for (int idx = (int)blockIdx.x * NWAVES * 64 + F.tid; idx < n; idx += stride) {
        const int bh = idx >> 14, el = idx & 16383; const bool hasn = el < 128;
        float m = 0.f, val = 0.f, valn = 0.f;
        float* const pb = STC + (size_t)bh * ML_G * 16384 + el; float* const pn = STN + bh * ML_G * 128 + (hasn ? el : 0);
        float xs[ML_G], xn[ML_G], mgs[ML_G], bgs[ML_G];
#pragma unroll
        for (int gi = 0; gi < ML_G; ++gi) { xs[gi] = pb[(size_t)gi * 16384]; xn[gi] = hasn ? pn[gi * 128] : 0.f; mgs[gi] = STS[(bh * ML_G + gi) * 4]; bgs[gi] = STS[(bh * ML_G + gi) * 4 + 1]; }
#pragma unroll
        for (int gi = 0; gi < ML_G; ++gi) { const int unit = bh * ML_G + gi;
            pb[(size_t)gi * 16384] = val; if (hasn) pn[gi * 128] = valn; if (el == 0) STS[unit * 4 + 2] = m;
            const float mn = fmaxf(bgs[gi] + m, mgs[gi]);
            const float ca = __expf(bgs[gi] + m - mn), cb = __expf(mgs[gi] - mn);
            val = ca * val + cb * xs[gi]; valn = ca * valn + cb * xn[gi]; m = mn; }
    }
}
#ifndef P6_ALIGN
#define P6_ALIGN true
#endif
#ifndef P2_ALIGN
#define P2_ALIGN true
#endif
#ifndef GB_MODE
#define GB_MODE 0
#endif
#ifndef REP_LW
#define REP_LW 1
#endif
#ifndef REP_P7
#define REP_P7 1
#endif
#ifndef REP_FB
#define REP_FB 1
#endif
#ifndef REP_BAR_MODE
#define REP_BAR_MODE 0
#endif
#ifndef REP_BAR
#define REP_BAR 0
#endif
#ifndef REP_P0
#define REP_P0 1
#endif
#ifndef REP_P1
#define REP_P1 1
#endif
#ifndef REP_P2
#define REP_P2 1
#endif
#ifndef REP_ML1
#define REP_ML1 1
#endif
#ifndef REP_ATT
#define REP_ATT 1
#endif
#ifndef REP_CMB
#define REP_CMB 1
#endif
#ifndef REP_ML2
#define REP_ML2 1
#endif
#ifndef REP_P4
#define REP_P4 1
#endif
#ifndef REP_P5
#define REP_P5 1
#endif
#ifndef REP_P6
#define REP_P6 1
#endif
struct Args { const float* in[18]; float* out; unsigned char* ws; int ph_lo, ph_hi, li, pad; };
__global__ void __launch_bounds__(NWAVES * 64, 2) blk_fwd(Args args) {
    extern __shared__ __attribute__((aligned(16))) unsigned char lds[];
    Frame F;
    F.lds = (LAS unsigned char*)lds;
    F.MISC = (volatile LAS unsigned*)(F.lds + MISC_OFF);
    F.tid = threadIdx.x; F.lane = F.tid & 63; F.wave = __builtin_amdgcn_readfirstlane(F.tid >> 6);
    F.G = gridDim.x; { const int bx = blockIdx.x; F.vcu = (F.G % 8 == 0) ? (bx % 8) * (F.G / 8) + bx / 8 : bx; }
    unsigned char* ws = args.ws; F.ws = ws;
    F.ctl = (gu32*)(ws + WS_CTL);
    F.x = args.in[0]; F.c = args.in[1]; F.g_mix = args.in[2]; F.w_in = args.in[3]; F.w_conv = args.in[4]; F.b_conv = args.in[5]; F.b_ig = args.in[6]; F.b_fg = args.in[7];
    F.qn_g = args.in[8]; F.kn_g = args.in[9]; F.mn_g = args.in[10]; F.w_out = args.in[11]; F.g_ffn = args.in[12]; F.w_gate = args.in[13]; F.w_up = args.in[14]; F.w_down = args.in[15];
    F.w_ada = args.in[16]; F.b_ada = args.in[17]; F.out = args.out;
    for (int u = F.tid; u < (LDS_BYTES - LDSCTL_OFF) / 4; u += NWAVES * 64) ((LAS unsigned*)(F.lds + LDSCTL_OFF))[u] = 0u;
    __syncthreads();
    const int lo = args.ph_lo, hi = args.ph_hi;
    XcdBarrier bar; bar.bar = (unsigned*)(F.ctl + CW_BAR) + args.li * XCD_BAR_WORDS; bar.x = 0; bar.st = nullptr;
    if (hi - lo > 1) bar = xcd_barrier_post((unsigned*)(F.ctl + CW_BAR) + args.li * XCD_BAR_WORDS, F.MISC + 8);
#define IN(k) (lo <= (k) && (k) < hi)
#define BOTH(k) (IN(k) && IN((k) + 1))
#ifndef BAR_REP
#define BAR_REP 0
#endif
#define GRID_BAR() do { _Pragma("unroll 1") for (int r_ = 0; r_ <= BAR_REP; ++r_) xcd_barrier<GB_MODE>(bar); } while (0)
    bf16* Win_t = (bf16*)(ws + WS_WIN); bf16* Wout_t = (bf16*)(ws + WS_WOUT); bf16* Wgu_t = (bf16*)(ws + WS_WGU); bf16* Wdn_t = (bf16*)(ws + WS_WDN);
    bf16* XN = (bf16*)(ws + WS_XN); bf16* XIN = (bf16*)(ws + WS_XIN); bf16* CAT = (bf16*)(ws + WS_CAT); bf16* HB = (bf16*)(ws + WS_H);
    float* mod = (float*)(ws + WS_MOD); float* gates = (float*)(ws + WS_GATES); bf16* X1B = (bf16*)(ws + WS_X1B); bf16* HM = (bf16*)(ws + WS_HM); bf16* XIM = XIN - 1536;

    const bool fuse5 = (M / pg8::BM) * (D / pg8::BM) <= F.G && IN(4) && IN(5);
    const bool chain34 = fuse5 && IN(3);
    const bool chain46 = chain34 && IN(6);
    const bool chain67 = IN(6) && IN(7) && (M / pg8::BM) * (D / pg8::BM) <= F.G;
    const bool split0 = (F.G == 256);
    const bool chain12 = split0 && IN(1) && IN(2);
    const bool chain01 = chain12 && IN(0);
    if (IN(0)) {
        if (!chain01) { for (int rep = 0; rep < REP_P0; ++rep) { if (!split0) p0_prologue(F); else { p0_mod_wide(F, (int)blockIdx.x); p0_win_copy(F, 0, 256); } } if (BOTH(0)) GRID_BAR(); }
        else {
            p0_mod_wide(F, (int)blockIdx.x);
            asm volatile("s_waitcnt vmcnt(0)" ::: "memory");
            __syncthreads();
            if (F.tid == 0 && (blockIdx.x & 127) < 43) __hip_atomic_fetch_add((unsigned*)(F.ctl + CW_RBM), 1u, __ATOMIC_RELAXED, __HIP_MEMORY_SCOPE_AGENT);
            p0_win_copy(F, 0, 256);
            asm volatile("s_waitcnt vmcnt(0)" ::: "memory");
            __syncthreads();
            if (F.tid == 0) __hip_atomic_fetch_add((unsigned*)(F.ctl + CW_RBM) + 4, 1u, __ATOMIC_RELAXED, __HIP_MEMORY_SCOPE_AGENT);
        }
    }
    if (IN(1)) { if (!split0) { p0_win_copy(F, 0, F.G); __syncthreads(); } for (int rep = 0; rep < REP_P1; ++rep) { norm_rows<true>(F, F.x, F.g_mix, mod + 0 * D, mod + 1 * D, XN, gates, chain12, chain01 ? (unsigned*)(F.ctl + CW_RBM) : nullptr, (unsigned*)(F.ctl + CW_TMO)); __syncthreads(); }
        if (chain12) {
            asm volatile("s_waitcnt vmcnt(0)" ::: "memory");
            __syncthreads();
            if (F.tid == 0) __hip_atomic_fetch_add((unsigned*)(F.ctl + CW_RB1) + 4 * (F.vcu >> 2), 1u, __ATOMIC_RELAXED, __HIP_MEMORY_SCOPE_AGENT);
        } else if (BOTH(1)) GRID_BAR(); }
    if (IN(2)) {
        pg8::Gemm g{XN, Win_t, M, NIN, D}; pg8::StaticOrder S; S.init(M, NIN, F.G, (int)blockIdx.x);
        if (chain12) {
            if (F.tid < 64) {
                const int l = F.lane; pg8::Unit ul; ul.pm = 0; bool have = false; if (l < 8) have = S.next(l, ul);
                unsigned* c1 = (unsigned*)(F.ctl + CW_RB1) + 4 * ul.pm; unsigned* tmo = (unsigned*)(F.ctl + CW_TMO); unsigned sp = 0u; unsigned need = 4u;
                if (chain01 && l == 8) { have = true; c1 = (unsigned*)(F.ctl + CW_RBM) + 4; need = 256u; }
                for (;;) {
                    const bool ok = !have || __hip_atomic_load(c1, __ATOMIC_RELAXED, __HIP_MEMORY_SCOPE_AGENT) >= need;
                    if (__all(ok)) break;
                    __builtin_amdgcn_s_sleep(1);
                    if ((++sp & 255u) == 0u) { if (__builtin_amdgcn_readfirstlane((int)__hip_atomic_load(tmo, __ATOMIC_RELAXED, __HIP_MEMORY_SCOPE_AGENT)) != 0) break; if (sp > (1u << 18)) { if (l == 0) atomicAdd(tmo, 1u); break; } } }
                __builtin_amdgcn_fence(__ATOMIC_ACQUIRE, "agent");
            }
            __syncthreads();
        }
        pg8::EpiBf16HM E{XIM, NXM, (unsigned)((size_t)M * NXM * 2 + 3072), HM, SEQ};
        for (int rep = 0; rep < REP_P2; ++rep) pg8::gemm_phase<pg8::EpiBf16HM, pg8::StaticOrder, P2_ALIGN, true>(F.lds + RING_OFF, g, S, E);
        { const int nu = (M / 256) * (NIN / 256); const int first = (nu % F.G) ? (nu % F.G) : 0; __syncthreads(); for (int rep = 0; rep < REP_LW; ++rep) p0_late_weights(F, first); }
        if (BOTH(2)) GRID_BAR();
    }
    if (IN(3)) {
        bf16* OP = (bf16*)F.out; float* LSE = (float*)((unsigned char*)F.out + 48 * MiB);
        for (int rep = 0; rep < REP_ML1; ++rep) mlstm_pass1(F, XIM, gates, XN);
        for (int rep = 0; rep < REP_ATT; ++rep) attn_phase<false>(F, HM, OP, LSE, CAT, 1024, AT_UNITS);
        GRID_BAR();
        mlstm_scan(F);
        for (int rep = 0; rep < REP_CMB; ++rep) attn_phase<true>(F, HM, OP, LSE, CAT, 0, 1024);
        GRID_BAR();
        for (int rep = 0; rep < REP_ML2; ++rep) mlstm_pass2(F, XIM, XN, gates, CAT);
        if (chain34) {
            asm volatile("s_waitcnt vmcnt(0)" ::: "memory");
            __syncthreads();
            if (F.tid == 0) for (int unit = F.vcu; unit < ML_UNITS; unit += F.G) { const int bh = unit / ML_G, grp = unit % ML_G;
                __hip_atomic_fetch_add((unsigned*)(F.ctl + CW_RB2) + 4 * ((bh >> 2) * (SEQ / 256) + grp), 1u, __ATOMIC_RELAXED, __HIP_MEMORY_SCOPE_AGENT); }
        } else if (BOTH(3)) GRID_BAR();
    }
    if (IN(4)) {
        pg8::Gemm g{CAT, Wout_t, M, D, D}; pg8::StaticOrder S; S.init(M, D, F.G, (int)blockIdx.x);
        pg8::Unit u0; u0.pm = 0; (void)S.next(0, u0);
        if (chain34) {
            if (F.tid == 0) { unsigned* c = (unsigned*)(F.ctl + CW_RB2) + 4 * u0.pm; unsigned* tmo = (unsigned*)(F.ctl + CW_TMO); unsigned sp = 0u;
                while (__hip_atomic_load(c, __ATOMIC_RELAXED, __HIP_MEMORY_SCOPE_AGENT) < 4u) { __builtin_amdgcn_s_sleep(1);
                    if ((++sp & 255u) == 0u) { if (__hip_atomic_load(tmo, __ATOMIC_RELAXED, __HIP_MEMORY_SCOPE_AGENT)) break; if (sp > (1u << 18)) { atomicAdd(tmo, 1u); break; } } }
                __builtin_amdgcn_fence(__ATOMIC_ACQUIRE, "agent"); }
            __syncthreads();
        }
        if (fuse5) {
            pg8::EpiResNorm E{F.x, X1B, XN, D, mod + 2 * D, F.g_ffn, mod + 3 * D, mod + 4 * D, NMOD, SEQ, (size_t)M * D * 2, (float*)(ws + WS_AUX), (unsigned*)(F.ctl + CW_RB), (unsigned*)(F.ctl + CW_TMO), M, D / pg8::BM, RMS_EPS};
            pg8::gemm_phase<pg8::EpiResNorm, pg8::StaticOrder, true, true>(F.lds + RING_OFF, g, S, E);
        } else {
            pg8::EpiResToB16 E{F.x, X1B, D, mod + 2 * D, NMOD, SEQ, (size_t)M * D * 2};
            for (int rep = 0; rep < REP_P4; ++rep) pg8::gemm_phase<pg8::EpiResToB16, pg8::StaticOrder, true, true>(F.lds + RING_OFF, g, S, E);
        }
        if (chain46) {
            asm volatile("s_waitcnt vmcnt(0)" ::: "memory");
            __syncthreads();
            if (F.tid == 0) __hip_atomic_fetch_add((unsigned*)(F.ctl + CW_RB3) + 4 * u0.pm, 1u, __ATOMIC_RELAXED, __HIP_MEMORY_SCOPE_AGENT);
        } else if (BOTH(4)) GRID_BAR();
    }
    if (IN(5) && !fuse5) { for (int rep = 0; rep < REP_P5; ++rep) norm_rows<false, true>(F, (const float*)X1B, F.g_ffn, mod + 3 * D, mod + 4 * D, XN, nullptr); if (BOTH(5)) GRID_BAR(); }
    if (IN(6)) {
        pg8::Gemm g{XN, Wgu_t, M, NGU, D}; pg8::StaticOrder S; S.init(M, NGU, F.G, (int)blockIdx.x, true);
        if (chain46) {
            if (F.tid < 64) {
                const int l = F.lane; pg8::Unit ul; ul.pm = 0; bool have = false; if (l < 8) have = S.next(l, ul);
                unsigned* c2 = (unsigned*)(F.ctl + CW_RB2) + 4 * l; unsigned* c3 = (unsigned*)(F.ctl + CW_RB3) + 4 * ul.pm; unsigned* tmo = (unsigned*)(F.ctl + CW_TMO); unsigned sp = 0u;
                bool ok2 = false, ok3 = !have;
                for (;;) {
                    if (!ok2) ok2 = __hip_atomic_load(c2, __ATOMIC_RELAXED, __HIP_MEMORY_SCOPE_AGENT) >= 4u;
                    if (!ok3) ok3 = __hip_atomic_load(c3, __ATOMIC_RELAXED, __HIP_MEMORY_SCOPE_AGENT) >= 4u;
                    if (__all(ok2 && ok3)) break;
                    __builtin_amdgcn_s_sleep(2);
                    if ((++sp & 255u) == 0u) { if (__builtin_amdgcn_readfirstlane((int)__hip_atomic_load(tmo, __ATOMIC_RELAXED, __HIP_MEMORY_SCOPE_AGENT)) != 0) break; if (sp > (1u << 18)) { if (l == 0) atomicAdd(tmo, 1u); break; } } }
                __builtin_amdgcn_fence(__ATOMIC_ACQUIRE, "agent");
            }
            __syncthreads();
        }
        pg8::EpiSwiGLU E{HB, FF, (unsigned)((size_t)M * FF * 2)};
        for (int rep = 0; rep < REP_P6; ++rep) pg8::gemm_phase<pg8::EpiSwiGLU, pg8::StaticOrder, P6_ALIGN, true>(F.lds + RING_OFF, g, S, E);
        if (chain67) {
            asm volatile("s_waitcnt vmcnt(0)" ::: "memory");
            __syncthreads();
            if (F.tid < 8) { pg8::Unit ul; ul.pm = 0; ul.half = -1; if (S.next(F.tid, ul)) __hip_atomic_fetch_add((unsigned*)(F.ctl + CW_RB4) + 4 * ul.pm, ul.half < 0 ? 2u : 1u, __ATOMIC_RELAXED, __HIP_MEMORY_SCOPE_AGENT); }
        } else if (BOTH(6)) GRID_BAR();
    }
    if (IN(7)) {
        pg8::Gemm g{HB, Wdn_t, M, D, FF}; pg8::StaticOrder S; S.init(M, D, F.G, (int)blockIdx.x);
        if (chain67) {
            pg8::Unit u7; u7.pm = 0; (void)S.next(0, u7);
            if (F.tid == 0) { unsigned* c = (unsigned*)(F.ctl + CW_RB4) + 4 * u7.pm; unsigned* tmo = (unsigned*)(F.ctl + CW_TMO); unsigned sp = 0u;
                while (__hip_atomic_load(c, __ATOMIC_RELAXED, __HIP_MEMORY_SCOPE_AGENT) < 2u * (NGU / 256)) { __builtin_amdgcn_s_sleep(1);
                    if ((++sp & 255u) == 0u) { if (__hip_atomic_load(tmo, __ATOMIC_RELAXED, __HIP_MEMORY_SCOPE_AGENT)) break; if (sp > (1u << 18)) { atomicAdd(tmo, 1u); break; } } }
                __builtin_amdgcn_fence(__ATOMIC_ACQUIRE, "agent"); }
            __syncthreads();
        }
        pg8::EpiResFromB16 E{X1B, F.out, D, mod + 5 * D, NMOD, SEQ};
        for (int rep = 0; rep < REP_P7; ++rep) pg8::gemm_phase<pg8::EpiResFromB16, pg8::StaticOrder, true, true>(F.lds + RING_OFF, g, S, E);
    }
#undef IN
#undef BOTH
}

extern "C" void kernel_launch(void* const* d_in, const int* in_sizes, int n_in, void* d_out, int out_size, void* d_ws, size_t ws_size, hipStream_t stream) {
    static int grid = 0;
    if (grid == 0) {
        if (n_in != 18 || out_size != M * D || ws_size < WS_END) { fprintf(stderr, "kernel_launch: unexpected shapes n_in %d out %d ws %zu\n", n_in, out_size, ws_size); grid = -1; return; }
        int dev = 0, cus = 0;
        if (hipGetDevice(&dev) != hipSuccess || hipDeviceGetAttribute(&cus, hipDeviceAttributeMultiprocessorCount, dev) != hipSuccess) { grid = -1; return; }
        if (hipFuncSetAttribute((const void*)blk_fwd, hipFuncAttributeMaxDynamicSharedMemorySize, LDS_BYTES) != hipSuccess) { fprintf(stderr, "kernel_launch: hipFuncSetAttribute failed\n"); grid = -1; return; }
        int per_cu = 0;
        if (hipOccupancyMaxActiveBlocksPerMultiprocessor(&per_cu, (const void*)blk_fwd, NWAVES * 64, LDS_BYTES) != hipSuccess || per_cu < 1) { fprintf(stderr, "kernel_launch: occupancy query reports %d workgroups per CU; nothing launched\n", per_cu); (void)hipGetLastError(); grid = -1; return; }
        grid = cus;
    }
    if (grid < 0) return;
    (void)hipMemsetAsync((char*)d_ws + WS_CTL, 0, CTL_ZERO_BYTES, stream);
    Args a{};
    for (int i = 0; i < 18; ++i) a.in[i] = (const float*)d_in[i];
    a.out = (float*)d_out; a.ws = (unsigned char*)d_ws;
    int li = 0;
    auto run = [&](int lo, int hi) { a.ph_lo = lo; a.ph_hi = hi; a.li = li++; hipLaunchKernelGGL(blk_fwd, dim3(grid), dim3(NWAVES * 64), LDS_BYTES, stream, a); };
    run(0, 8);
}
```
